# Optimizing an MI355X kernel written in HIP

```python
import math
import jax, jax.numpy as jnp
from jax import lax
import numpy as np

D_MODEL = 1024
BATCH = 8
SEQ = 4096
DEPTH = 1

CHUNK = 64
Q_BLOCK = 128
D_MIX = D_MODEL
ATTN_HEADS = 8
HEAD_DIM = 64
D_ATTN = ATTN_HEADS * HEAD_DIM
D_SSM = D_MIX - D_ATTN
SSM_GROUP = 16
SSM_GROUPS = D_SSM // SSM_GROUP
SSM_STATE = 64
D_FF = -(-(8 * D_MODEL) // (3 * 256)) * 256
D_IN = 3 * D_ATTN + D_SSM
EPS = 1e-6
DT_MIN = 1e-3
DT_MAX = 1e-1

kernel_name = "hymba_stickbreaking_s5_block"


def rmsnorm(x, g):
    xf = x.astype(jnp.float32)
    xf = xf * lax.rsqrt(jnp.mean(xf * xf, axis=-1, keepdims=True) + EPS)
    return xf.astype(x.dtype) * g


def stick_breaking_attention(q, k, v):
    seq_len = q.shape[2]
    scale = HEAD_DIM ** -0.5
    outs = []
    for blk in range(seq_len // Q_BLOCK):
        q0 = blk * Q_BLOCK
        kv_len = q0 + Q_BLOCK
        qb = q[:, :, q0:kv_len]
        kb = k[:, :, :kv_len]
        vb = v[:, :, :kv_len]
        z = jnp.einsum('bhqd,bhkd->bhqk', qb, kb).astype(jnp.float32) * scale
        t_pos = q0 + jnp.arange(Q_BLOCK)[:, None]
        s_pos = jnp.arange(kv_len)[None, :]
        before = s_pos < t_pos
        log1m = jnp.where(before, -jax.nn.softplus(z), 0.0)
        rc = lax.cumsum(log1m, axis=3, reverse=True)
        log_w = jax.nn.log_sigmoid(z) + (rc - log1m)
        w = jnp.where(before, jnp.exp(log_w), 0.0)
        outs.append(jnp.einsum('bhqk,bhkd->bhqd', w.astype(vb.dtype), vb))
    return jnp.concatenate(outs, axis=2)


def _ssm_combine(a, b):
    a_lr, a_li, a_xr, a_xi = a
    b_lr, b_li, b_xr, b_xi = b
    lr = a_lr * b_lr - a_li * b_li
    li = a_lr * b_li + a_li * b_lr
    xr = b_lr * a_xr - b_li * a_xi + b_xr
    xi = b_lr * a_xi + b_li * a_xr + b_xi
    return (lr, li, xr, xi)


def s5_ssm(u, lambda_re, lambda_im, log_step, b_re, b_im, c_re, c_im, d_skip):
    bsz, seq_len, _ = u.shape
    ug = u.reshape(bsz, seq_len, SSM_GROUPS, SSM_GROUP).astype(jnp.float32)
    lam_re = lambda_re.astype(jnp.float32)
    lam_im = lambda_im.astype(jnp.float32)
    dt = jnp.exp(log_step.astype(jnp.float32))[:, None]
    mag = jnp.exp(lam_re * dt)
    ang = lam_im * dt
    lb_re = mag * jnp.cos(ang)
    lb_im = mag * jnp.sin(ang)
    den = lam_re * lam_re + lam_im * lam_im
    num_re = lb_re - 1.0
    f_re = (num_re * lam_re + lb_im * lam_im) / den
    f_im = (lb_im * lam_re - num_re * lam_im) / den
    br = b_re.astype(jnp.float32)
    bi = b_im.astype(jnp.float32)
    bb_re = f_re[..., None] * br - f_im[..., None] * bi
    bb_im = f_re[..., None] * bi + f_im[..., None] * br
    bu_re = jnp.einsum('blgh,gph->blgp', ug, bb_re)
    bu_im = jnp.einsum('blgh,gph->blgp', ug, bb_im)
    a_re = jnp.broadcast_to(lb_re, bu_re.shape)
    a_im = jnp.broadcast_to(lb_im, bu_im.shape)
    _, _, x_re, x_im = lax.associative_scan(_ssm_combine, (a_re, a_im, bu_re, bu_im), axis=1)
    y = (jnp.einsum('blgp,ghp->blgh', x_re, c_re.astype(jnp.float32))
         - jnp.einsum('blgp,ghp->blgh', x_im, c_im.astype(jnp.float32))
         + d_skip.astype(jnp.float32) * ug)
    return y.reshape(bsz, seq_len, D_SSM).astype(u.dtype)


def setup_inputs(seed: int = 0) -> dict:
    key = jax.random.key(seed)
    ks = jax.random.split(key, 24)
    f32 = jnp.float32
    G, P, H = SSM_GROUPS, SSM_STATE, SSM_GROUP
    x = jax.random.normal(ks[0], (BATCH, SEQ, D_MODEL), f32)
    norm1_g = 1.0 + 0.02 * jax.random.normal(ks[1], (DEPTH, D_MODEL), f32)
    w_in = jax.random.normal(ks[2], (DEPTH, D_MODEL, D_IN), f32) * D_MODEL ** -0.5
    attn_norm_g = 1.0 + 0.02 * jax.random.normal(ks[3], (DEPTH, D_ATTN), f32)
    lambda_re = -0.5 + 0.01 * jax.random.normal(ks[4], (DEPTH, G, P), f32)
    lambda_im = (math.pi * jnp.arange(P, dtype=f32))[None, None, :] + 0.01 * jax.random.normal(ks[5], (DEPTH, G, P), f32)
    log_step = jax.random.uniform(ks[6], (DEPTH, G), f32, math.log(DT_MIN), math.log(DT_MAX))
    b_re = jax.random.normal(ks[7], (DEPTH, G, P, H), f32) * (2.0 * H) ** -0.5
    b_im = jax.random.normal(ks[8], (DEPTH, G, P, H), f32) * (2.0 * H) ** -0.5
    c_re = jax.random.normal(ks[9], (DEPTH, G, H, P), f32) * (2.0 * P) ** -0.5
    c_im = jax.random.normal(ks[10], (DEPTH, G, H, P), f32) * (2.0 * P) ** -0.5
    d_skip = jax.random.normal(ks[11], (DEPTH, G, H), f32)
    w_glu = jax.random.normal(ks[12], (DEPTH, D_SSM, D_SSM), f32) * D_SSM ** -0.5
    ssm_norm_g = 1.0 + 0.02 * jax.random.normal(ks[13], (DEPTH, D_SSM), f32)
    w_out = jax.random.normal(ks[14], (DEPTH, D_MIX, D_MODEL), f32) * D_MIX ** -0.5
    norm2_g = 1.0 + 0.02 * jax.random.normal(ks[15], (DEPTH, D_MODEL), f32)
    w_gate = jax.random.normal(ks[16], (DEPTH, D_MODEL, D_FF), f32) * D_MODEL ** -0.5
    w_up = jax.random.normal(ks[17], (DEPTH, D_MODEL, D_FF), f32) * D_MODEL ** -0.5
    w_down = jax.random.normal(ks[18], (DEPTH, D_FF, D_MODEL), f32) * D_FF ** -0.5
    final_norm_g = 1.0 + 0.02 * jax.random.normal(ks[19], (D_MODEL,), f32)
    return {"x": x, "norm1_g": norm1_g, "w_in": w_in, "attn_norm_g": attn_norm_g,
            "lambda_re": lambda_re, "lambda_im": lambda_im, "log_step": log_step,
            "b_re": b_re, "b_im": b_im, "c_re": c_re, "c_im": c_im, "d_skip": d_skip,
            "w_glu": w_glu, "ssm_norm_g": ssm_norm_g, "w_out": w_out, "norm2_g": norm2_g,
            "w_gate": w_gate, "w_up": w_up, "w_down": w_down, "final_norm_g": final_norm_g}


def reference(x, norm1_g, w_in, attn_norm_g, lambda_re, lambda_im, log_step, b_re, b_im,
              c_re, c_im, d_skip, w_glu, ssm_norm_g, w_out, norm2_g, w_gate, w_up, w_down,
              final_norm_g):
    bsz, seq_len, _ = x.shape
    for i in range(DEPTH):
        h = rmsnorm(x, norm1_g[i])
        proj = h @ w_in[i]
        q = proj[..., :D_ATTN]
        k = proj[..., D_ATTN:2 * D_ATTN]
        v = proj[..., 2 * D_ATTN:3 * D_ATTN]
        u = proj[..., 3 * D_ATTN:]
        to_heads = lambda t: t.reshape(bsz, seq_len, ATTN_HEADS, HEAD_DIM).transpose(0, 2, 1, 3)
        o_attn = stick_breaking_attention(to_heads(q), to_heads(k), to_heads(v))
        o_attn = o_attn.transpose(0, 2, 1, 3).reshape(bsz, seq_len, D_ATTN)
        o_attn = rmsnorm(o_attn, attn_norm_g[i])
        y = s5_ssm(u, lambda_re[i], lambda_im[i], log_step[i], b_re[i], b_im[i],
                   c_re[i], c_im[i], d_skip[i])
        y = jax.nn.gelu(y)
        y = y * jax.nn.sigmoid(y @ w_glu[i])
        o_ssm = rmsnorm(y, ssm_norm_g[i])
        x = x + jnp.concatenate([o_attn, o_ssm], axis=-1) @ w_out[i]
        h = rmsnorm(x, norm2_g[i])
        x = x + (jax.nn.silu(h @ w_gate[i]) * (h @ w_up[i])) @ w_down[i]
    return rmsnorm(x, final_norm_g)
```

```cpp
#include <hip/hip_runtime.h>
#include <hip/hip_cooperative_groups.h>
#include <cstdio>
#include <cstdint>
namespace cg = cooperative_groups;

namespace pg8 {
#define PG8_LAS __attribute__((address_space(3)))
typedef unsigned short bf16_t;
typedef short bf16x8 __attribute__((ext_vector_type(8)));
typedef float f32x4 __attribute__((ext_vector_type(4)));
typedef float f32x2 __attribute__((ext_vector_type(2)));
typedef unsigned u32x4 __attribute__((ext_vector_type(4)));
typedef unsigned u32x2 __attribute__((ext_vector_type(2)));
constexpr int BM = 256, BK = 64, HALF = 128, HTB = HALF * BK * 2, STAGE_BYTES = 8 * HTB, NXCD = 8, WGM = 8;

__host__ __device__ __forceinline__ int lds_byte(int r, int c) { const int st = (r >> 4) * 2 + (c >> 5), rr = r & 15, cc = c & 31, ob = rr * 64 + cc * 2; return st * 1024 + (ob ^ (((ob >> 9) & 1) << 5)); }
__host__ __device__ __forceinline__ void stage_rc(int b, int& R, int& C) { const int st = b / 1024, sb = b % 1024, swz = sb ^ (((sb >> 9) & 1) << 5); R = (st >> 1) * 16 + swz / 64; C = (st & 1) * 32 + (swz % 64) / 2; }
__host__ __device__ __forceinline__ int perm32(int rho) { const int n = rho >> 4, i = rho & 15; return 8 * (i >> 2) + 4 * n + (i & 3); }

struct Unit { int pm, pn; };
struct Gemm { const bf16_t* A; const bf16_t* Bt; int M, N, K; };

struct StaticOrder {
    int nM, nN, nwg, G, c;
    __host__ __device__ void init(int M, int N, int G_, int c_) { nM = M / BM; nN = N / BM; nwg = nM * nN; G = G_; c = c_; }
    __host__ __device__ bool next(int i, Unit& u) const {
        const long L = (long)i * G + c; if (L >= nwg) return false;
        int wgid = (int)L; { const int q = nwg / NXCD, r = nwg % NXCD, xcd = wgid % NXCD, off = wgid / NXCD; wgid = (xcd < r ? xcd * (q + 1) : r * (q + 1) + (xcd - r) * q) + off; }
        const int nig = WGM * nN, gid = wgid / nig, fm = gid * WGM, gsz = (nM - fm) < WGM ? (nM - fm) : WGM;
        u.pm = fm + ((wgid % nig) % gsz); u.pn = (wgid % nig) / gsz; return true;
    }
    __device__ __forceinline__ void a_ready(const Unit&) const {}
    __device__ __forceinline__ void done(const Unit&) const {}
};

__device__ __forceinline__ unsigned cvt_pk_bf16(float lo, float hi) { unsigned r; asm volatile("v_cvt_pk_bf16_f32 %0, %1, %2" : "=v"(r) : "v"(lo), "v"(hi)); return r; }
__device__ __forceinline__ float bf_lo(unsigned w) { return __uint_as_float(w << 16); }
__device__ __forceinline__ float bf_hi(unsigned w) { return __uint_as_float(w & 0xffff0000u); }

struct EpiStore {
    static constexpr bool PERM = true;
    bf16_t* O; int ldc;
    __device__ __forceinline__ void operator()(const f32x4 (&acc)[2][2][4][2], const Unit& u, int wr, int wc, int fr, int fq) const {
        asm volatile("" : "+v"(fr), "+v"(fq));
        const int row0 = u.pm * BM + wr * 64 + fr, col0 = u.pn * BM + wc * 32 + 8 * fq;
#pragma unroll
        for (int ai = 0; ai < 2; ++ai)
#pragma unroll
            for (int m = 0; m < 4; ++m) { bf16_t* rowp = O + (size_t)(row0 + ai * HALF + m * 16) * ldc + col0;
#pragma unroll
                for (int bj = 0; bj < 2; ++bj) { const f32x4 v0 = acc[ai][bj][m][0], v1 = acc[ai][bj][m][1];
                    u32x4 w; w.x = cvt_pk_bf16(v0[0], v0[1]); w.y = cvt_pk_bf16(v0[2], v0[3]); w.z = cvt_pk_bf16(v1[0], v1[1]); w.w = cvt_pk_bf16(v1[2], v1[3]);
                    *(u32x4*)(rowp + bj * HALF) = w; } }
    }
};
__device__ __forceinline__ float sigmoidf_fast(float a) { return __builtin_amdgcn_rcpf(1.0f + __builtin_amdgcn_exp2f(-1.4426950408889634f * a)); }
struct EpiGlu {
    static constexpr bool PERM = true;
    const bf16_t* Y; bf16_t* Z; float* part;
    __device__ __forceinline__ void operator()(const f32x4 (&acc)[2][2][4][2], const Unit& u, int wr, int wc, int fr, int fq) const {
        asm volatile("" : "+v"(fr), "+v"(fq));
        const int row0 = u.pm * BM + wr * 64 + fr, col0 = u.pn * BM + wc * 32 + 8 * fq;
#pragma unroll
        for (int ai = 0; ai < 2; ++ai)
#pragma unroll
            for (int m = 0; m < 4; ++m) { const int row = row0 + ai * HALF + m * 16; float ss = 0.f;
#pragma unroll
                for (int bj = 0; bj < 2; ++bj) { const int col = col0 + bj * HALF;
                    const u32x4 yv = *(const u32x4*)(Y + (size_t)row * 512 + col);
                    const f32x4 a0 = acc[ai][bj][m][0], a1 = acc[ai][bj][m][1];
                    float v[8];
                    v[0] = bf_lo(yv.x) * sigmoidf_fast(a0[0]); v[1] = bf_hi(yv.x) * sigmoidf_fast(a0[1]);
                    v[2] = bf_lo(yv.y) * sigmoidf_fast(a0[2]); v[3] = bf_hi(yv.y) * sigmoidf_fast(a0[3]);
                    v[4] = bf_lo(yv.z) * sigmoidf_fast(a1[0]); v[5] = bf_hi(yv.z) * sigmoidf_fast(a1[1]);
                    v[6] = bf_lo(yv.w) * sigmoidf_fast(a1[2]); v[7] = bf_hi(yv.w) * sigmoidf_fast(a1[3]);
#pragma unroll
                    for (int e = 0; e < 8; ++e) ss += v[e] * v[e];
                    u32x4 w; w.x = cvt_pk_bf16(v[0], v[1]); w.y = cvt_pk_bf16(v[2], v[3]); w.z = cvt_pk_bf16(v[4], v[5]); w.w = cvt_pk_bf16(v[6], v[7]);
                    *(u32x4*)(Z + (size_t)row * 1024 + col) = w; }
                ss += __shfl_xor(ss, 16); ss += __shfl_xor(ss, 32);
                if (fq == 0) part[(size_t)row * 8 + u.pn * 4 + wc] = ss; asm volatile("" ::: "memory"); }
    }
};
struct EpiRes {
    static constexpr bool PERM = false;
    const float* base; float* out; bf16_t* xb; float* part;
    __device__ __forceinline__ void operator()(const f32x4 (&acc)[2][2][4][2], const Unit& u, int wr, int wc, int fr, int fq) const {
        asm volatile("" : "+v"(fr), "+v"(fq));
        const int row0 = u.pm * BM + wr * 64 + fr, col0 = u.pn * BM + wc * 32 + 4 * fq;
#pragma unroll
        for (int ai = 0; ai < 2; ++ai)
#pragma unroll
            for (int m = 0; m < 4; ++m) { const int row = row0 + ai * HALF + m * 16; float ss = 0.f; const size_t off = (size_t)row * 1024 + col0;
#pragma unroll
                for (int bj = 0; bj < 2; ++bj)
#pragma unroll
                    for (int n = 0; n < 2; ++n) { const size_t o2 = off + bj * HALF + n * 16;
                        const f32x4 b = *(const f32x4*)(base + o2); const f32x4 v = b + acc[ai][bj][m][n];
                        *(f32x4*)(out + o2) = v; ss += (v[0] * v[0] + v[1] * v[1]) + (v[2] * v[2] + v[3] * v[3]);
                        if (xb) { u32x2 w; w.x = cvt_pk_bf16(v[0], v[1]); w.y = cvt_pk_bf16(v[2], v[3]); *(u32x2*)(xb + o2) = w; } }
                ss += __shfl_xor(ss, 16); ss += __shfl_xor(ss, 32);
                if (fq == 0) part[(size_t)row * 16 + u.pn * 4 + wc] = ss; asm volatile("" ::: "memory"); }
    }
};
struct EpiGateUp {
    static constexpr bool PERM = true;
    bf16_t* H; const float* part; float eps;
    __device__ __forceinline__ void operator()(const f32x4 (&acc)[2][2][4][2], const Unit& u, int wr, int wc, int fr, int fq) const {
        asm volatile("" : "+v"(fr), "+v"(fq));
        const int row0 = u.pm * BM + wr * 64 + fr, col0 = u.pn * HALF + wc * 32 + 8 * fq;
#pragma unroll
        for (int ai = 0; ai < 2; ++ai)
#pragma unroll
            for (int m = 0; m < 4; ++m) { const int row = row0 + ai * HALF + m * 16;
                const f32x4* pp = (const f32x4*)(part + (size_t)row * 16); const f32x4 p0 = pp[0], p1 = pp[1], p2 = pp[2], p3 = pp[3];
                const float s = ((p0[0] + p0[1]) + (p0[2] + p0[3])) + ((p1[0] + p1[1]) + (p1[2] + p1[3])) + ((p2[0] + p2[1]) + (p2[2] + p2[3])) + ((p3[0] + p3[1]) + (p3[2] + p3[3]));
                const float rs = 1.0f / sqrtf(s * (1.0f / 1024.0f) + eps);
                float v[8];
#pragma unroll
                for (int n = 0; n < 2; ++n)
#pragma unroll
                    for (int e = 0; e < 4; ++e) { const float g = acc[ai][0][m][n][e] * rs, up = acc[ai][1][m][n][e] * rs; v[n * 4 + e] = g * sigmoidf_fast(g) * up; }
                u32x4 w; w.x = cvt_pk_bf16(v[0], v[1]); w.y = cvt_pk_bf16(v[2], v[3]); w.z = cvt_pk_bf16(v[4], v[5]); w.w = cvt_pk_bf16(v[6], v[7]);
                *(u32x4*)(H + (size_t)row * 2816 + col0) = w; if (m & 1) asm volatile("" ::: "memory"); }
    }
};

template <class Epi, class Sched, bool ALIGN_EPI, bool SP2, bool MID>
__device__ __forceinline__ void gemm_phase(PG8_LAS unsigned char* lds, const Gemm g, const Sched& S, const Epi& E, const float* midp, float mid_eps) {
    int tid = threadIdx.x; asm volatile("" : "+v"(tid));
    const int wid = __builtin_amdgcn_readfirstlane(tid >> 6), lane = tid & 63, wr = wid >> 2, wc = wid & 3, fr = lane & 15, fq = lane >> 4;
    const int K = g.K, nt = K / BK;
    unsigned voffA[2], voffB[2];
#pragma unroll
    for (int i = 0; i < 2; ++i) { int R, C; stage_rc(tid * 16 + i * 8192, R, C); const int Rb = Epi::PERM ? ((R & ~31) + perm32(R & 31)) : R;
        voffA[i] = (unsigned)(R * K + C) * 2u; voffB[i] = (unsigned)(Rb * K + C) * 2u; }
    const size_t kstep = (size_t)(BK * 2);
    const size_t hstep = (size_t)HALF * K * 2;
    const size_t tstep = 2 * hstep;
    const unsigned ldsw = (unsigned)wid * 1024u;
    const int aoff = lds_byte(wr * 64 + fr, fq * 8), boff = lds_byte(wc * 32 + fr, fq * 8);
#define PG8_SA(b, h) (((b) * 2 + (h)) * HTB)
#define PG8_SB(b, h) ((4 + (b) * 2 + (h)) * HTB)
#define PG8_STAGE(bufoff, gbase, voff) do { _Pragma("unroll") for (int _i = 0; _i < 2; ++_i) \
        __builtin_amdgcn_global_load_lds((const unsigned*)((const char*)(gbase) + (voff)[_i]), (PG8_LAS unsigned*)(lds + (bufoff) + ldsw + _i * 8192), 16, 0, 0); } while (0)
#define PG8_LDA(dst, b, h) do { _Pragma("unroll") for (int m = 0; m < 4; ++m) _Pragma("unroll") for (int k = 0; k < 2; ++k) dst[m][k] = *(const PG8_LAS bf16x8*)(lds + PG8_SA(b, h) + aoff + m * 2048 + k * 1024); } while (0)
#define PG8_LDB(dst, b, h) do { _Pragma("unroll") for (int n = 0; n < 2; ++n) _Pragma("unroll") for (int k = 0; k < 2; ++k) dst[n][k] = *(const PG8_LAS bf16x8*)(lds + PG8_SB(b, h) + boff + n * 2048 + k * 1024); } while (0)
#define PG8_MMA(ai, bj, At, Bt) do { __builtin_amdgcn_s_setprio(1); _Pragma("unroll") for (int m = 0; m < 4; ++m) _Pragma("unroll") for (int n = 0; n < 2; ++n) _Pragma("unroll") for (int k = 0; k < 2; ++k) \
        acc[ai][bj][m][n] = __builtin_amdgcn_mfma_f32_16x16x32_bf16(Bt[n][k], At[m][k], acc[ai][bj][m][n], 0, 0, 0); __builtin_amdgcn_s_setprio(0); } while (0)
#define PG8_WAIT_V(n) asm volatile("s_waitcnt vmcnt(" #n ")" ::: "memory")
#define PG8_WAIT_L(n) asm volatile("s_waitcnt lgkmcnt(" #n ")" ::: "memory")
#define PG8_BAR __builtin_amdgcn_s_barrier()
#define PG8_SCHED __builtin_amdgcn_sched_barrier(0)
    Unit cur, nxt; int ui = 0;
    if (!S.next(0, cur)) return;
    f32x4 acc[2][2][4][2];
#pragma unroll
    for (int a = 0; a < 2; ++a)
#pragma unroll
        for (int b = 0; b < 2; ++b)
#pragma unroll
            for (int m = 0; m < 4; ++m)
#pragma unroll
                for (int n = 0; n < 2; ++n) acc[a][b][m][n] = (f32x4){0.f, 0.f, 0.f, 0.f};
    bf16x8 At[4][2], B0[2][2], B1[2][2];
    const char* cA = (const char*)g.A + (size_t)cur.pm * tstep; const char* cB = (const char*)g.Bt + (size_t)cur.pn * tstep;
    if constexpr (SP2) {
        PG8_STAGE(PG8_SB(0, 0), cB, voffB); PG8_STAGE(PG8_SB(0, 1), cB + hstep, voffB); PG8_STAGE(PG8_SA(0, 0), cA, voffA); PG8_STAGE(PG8_SA(0, 1), cA + hstep, voffA);
        if (wr == 1) PG8_BAR;
        PG8_WAIT_V(2); PG8_BAR;
        PG8_STAGE(PG8_SB(1, 0), cB + kstep, voffB); PG8_STAGE(PG8_SA(1, 0), cA + kstep, voffA); PG8_STAGE(PG8_SB(1, 1), cB + hstep + kstep, voffB);
        PG8_WAIT_V(6); PG8_BAR;
    } else {
        PG8_STAGE(PG8_SB(0, 0), cB, voffB); PG8_STAGE(PG8_SA(0, 0), cA, voffA); PG8_STAGE(PG8_SB(0, 1), cB + hstep, voffB); PG8_STAGE(PG8_SA(0, 1), cA + hstep, voffA);
        if (wr == 1) PG8_BAR;
        PG8_WAIT_V(4); PG8_BAR;
        PG8_STAGE(PG8_SB(1, 0), cB + kstep, voffB); PG8_STAGE(PG8_SA(1, 0), cA + kstep, voffA); PG8_STAGE(PG8_SB(1, 1), cB + hstep + kstep, voffB);
        PG8_WAIT_V(6); PG8_BAR;
    }
    for (;;) {
        const bool has_next = S.next(ui + 1, nxt);
        const char* nA = has_next ? (const char*)g.A + (size_t)nxt.pm * tstep : cA; const char* nB = has_next ? (const char*)g.Bt + (size_t)nxt.pn * tstep : cB;
        for (int t = 0; t < nt; t += 2) {
            const bool last = (t == nt - 2);
            const char* a1 = cA + (size_t)(t + 1) * kstep;
            const char* a2 = last ? nA : cA + (size_t)(t + 2) * kstep; const char* b2 = last ? nB : cB + (size_t)(t + 2) * kstep;
            const char* a3 = a2 + kstep; const char* b3 = b2 + kstep;
            if constexpr (MID) {
                if (t == (nt >> 1)) {
                    PG8_SCHED;
#pragma unroll
                    for (int ai = 0; ai < 2; ++ai)
#pragma unroll
                        for (int m = 0; m < 4; ++m) { const int row = cur.pm * BM + ai * HALF + wr * 64 + m * 16 + fr;
                            const f32x4 p0 = *(const f32x4*)(midp + (size_t)row * 8), p1 = *(const f32x4*)(midp + (size_t)row * 8 + 4);
                            const float s = ((p0[0] + p0[1]) + (p0[2] + p0[3])) + ((p1[0] + p1[1]) + (p1[2] + p1[3]));
                            const float rs = 1.0f / sqrtf(s * (1.0f / 512.0f) + mid_eps);
#pragma unroll
                            for (int bj = 0; bj < 2; ++bj)
#pragma unroll
                                for (int n = 0; n < 2; ++n) acc[ai][bj][m][n] = acc[ai][bj][m][n] * rs; asm volatile("" ::: "memory"); }
                    PG8_WAIT_V(0);
                    PG8_SCHED;
                }
            }
            if constexpr (SP2) {
            PG8_LDB(B0, 0, 0); PG8_LDB(B1, 0, 1); PG8_SCHED; PG8_LDA(At, 0, 0); PG8_STAGE(PG8_SA(1, 1), a1 + hstep, voffA);
            PG8_WAIT_V(8); PG8_WAIT_L(0); PG8_BAR; PG8_MMA(0, 0, At, B0); PG8_MMA(0, 1, At, B1); PG8_BAR; PG8_SCHED;
            PG8_LDA(At, 0, 1); PG8_STAGE(PG8_SB(0, 0), b2, voffB); PG8_STAGE(PG8_SB(0, 1), b2 + hstep, voffB); PG8_STAGE(PG8_SA(0, 0), a2, voffA);
            PG8_WAIT_V(8); PG8_WAIT_L(0); PG8_BAR; PG8_MMA(1, 0, At, B0); PG8_MMA(1, 1, At, B1); PG8_BAR; PG8_SCHED;
            PG8_LDB(B0, 1, 0); PG8_LDB(B1, 1, 1); PG8_SCHED; PG8_LDA(At, 1, 0); PG8_STAGE(PG8_SA(0, 1), a2 + hstep, voffA);
            PG8_WAIT_V(8); PG8_WAIT_L(0); PG8_BAR; PG8_MMA(0, 0, At, B0); PG8_MMA(0, 1, At, B1); PG8_BAR; PG8_SCHED;
            PG8_LDA(At, 1, 1); PG8_STAGE(PG8_SB(1, 0), b3, voffB); PG8_STAGE(PG8_SB(1, 1), b3 + hstep, voffB); PG8_STAGE(PG8_SA(1, 0), a3, voffA);
            PG8_WAIT_V(8); PG8_WAIT_L(0); PG8_BAR; PG8_MMA(1, 0, At, B0); PG8_MMA(1, 1, At, B1); PG8_BAR; PG8_SCHED;
            } else {
            PG8_LDB(B0, 0, 0); PG8_SCHED; PG8_LDA(At, 0, 0); PG8_STAGE(PG8_SA(1, 1), a1 + hstep, voffA);
            PG8_WAIT_L(8); PG8_BAR; PG8_WAIT_L(0); PG8_MMA(0, 0, At, B0); PG8_BAR; PG8_SCHED;
            PG8_LDB(B1, 0, 1); PG8_STAGE(PG8_SB(0, 0), b2, voffB);
            PG8_BAR; PG8_WAIT_L(0); PG8_MMA(0, 1, At, B1); PG8_BAR;
            PG8_LDA(At, 0, 1); PG8_STAGE(PG8_SA(0, 0), a2, voffA);
            PG8_BAR; PG8_WAIT_L(0); PG8_MMA(1, 0, At, B0); PG8_BAR; PG8_SCHED;
            PG8_STAGE(PG8_SB(0, 1), b2 + hstep, voffB);
            PG8_WAIT_V(6); PG8_BAR; PG8_MMA(1, 1, At, B1); PG8_BAR;
            PG8_LDB(B0, 1, 0); PG8_SCHED; PG8_LDA(At, 1, 0); PG8_STAGE(PG8_SA(0, 1), a2 + hstep, voffA);
            PG8_WAIT_L(8); PG8_BAR; PG8_WAIT_L(0); PG8_MMA(0, 0, At, B0); PG8_BAR; PG8_SCHED;
            PG8_LDB(B1, 1, 1); PG8_STAGE(PG8_SB(1, 0), b3, voffB);
            PG8_BAR; PG8_WAIT_L(0); PG8_MMA(0, 1, At, B1); PG8_BAR;
            PG8_LDA(At, 1, 1); PG8_STAGE(PG8_SA(1, 0), a3, voffA);
            PG8_BAR; PG8_WAIT_L(0); PG8_MMA(1, 0, At, B0); PG8_BAR; PG8_SCHED;
            PG8_STAGE(PG8_SB(1, 1), b3 + hstep, voffB);
            PG8_WAIT_V(6); PG8_BAR; PG8_MMA(1, 1, At, B1); PG8_BAR;
            }
        }
        if constexpr (ALIGN_EPI) { if (wr == 0) PG8_BAR; }
        E(acc, cur, wr, wc, fr, fq);
        if (!has_next) break;
#pragma unroll
        for (int a = 0; a < 2; ++a)
#pragma unroll
            for (int b = 0; b < 2; ++b)
#pragma unroll
                for (int m = 0; m < 4; ++m)
#pragma unroll
                    for (int n = 0; n < 2; ++n) acc[a][b][m][n] = (f32x4){0.f, 0.f, 0.f, 0.f};
        cur = nxt; cA = nA; cB = nB; ++ui;
        if constexpr (ALIGN_EPI) { if (wr == 1) PG8_BAR; }
    }
    PG8_WAIT_V(0);
    if constexpr (!ALIGN_EPI) { if (wr == 0) PG8_BAR; }
    PG8_BAR;
#undef PG8_SA
#undef PG8_SB
#undef PG8_STAGE
#undef PG8_LDA
#undef PG8_LDB
#undef PG8_MMA
#undef PG8_WAIT_V
#undef PG8_WAIT_L
#undef PG8_BAR
#undef PG8_SCHED
}
}

using pg8::bf16_t; using pg8::bf16x8; using pg8::f32x4; using pg8::u32x4; using pg8::u32x2; using pg8::cvt_pk_bf16;
typedef float f32x16 __attribute__((ext_vector_type(16)));
typedef short s16x4 __attribute__((ext_vector_type(4)));
constexpr int NB = 8, SEQ = 4096, DM = 1024, MTOK = NB * SEQ;
constexpr int NHEAD = 8, HD = 64, DATT = 512, DSSM = 512, NGRP = 32, GCH = 16, NST = 64, DFF = 2816;
constexpr int PROJ_LD = 1536;
constexpr float EPS = 1e-6f;
constexpr int NWAVES = 8, NTHR = 512;
constexpr int LDS_BYTES = 147456;

constexpr size_t MiB = 1u << 20;
constexpr size_t WS_WIN = 1 * MiB;
constexpr size_t WS_WGLU = 5 * MiB;
constexpr size_t WS_WOUT = 6 * MiB;
constexpr size_t WS_WGU = 8 * MiB;
constexpr size_t WS_WDN = 20 * MiB;
constexpr size_t WS_SSM = 26 * MiB;
constexpr size_t WS_LAM16 = 34 * MiB;
constexpr size_t WS_PART1 = 35 * MiB;
constexpr size_t WS_PART2 = 36 * MiB;
constexpr size_t WS_PART3 = 38 * MiB;
constexpr size_t WS_XN = 48 * MiB;
constexpr size_t WS_Z = 112 * MiB;
constexpr size_t WS_VT = 176 * MiB;
constexpr size_t WS_PROJ = 208 * MiB;
constexpr size_t WS_YG = 304 * MiB;
constexpr size_t WS_H = 176 * MiB;
constexpr size_t WS_END = 352 * MiB;

__device__ __forceinline__ int crow(int r, int hi) { return (r & 3) + 8 * (r >> 2) + 4 * hi; }
__device__ __forceinline__ float2 cmul(float2 a, float2 b) { return make_float2(a.x * b.x - a.y * b.y, a.x * b.y + a.y * b.x); }
__device__ __forceinline__ unsigned short bf1(float v) { return (unsigned short)(cvt_pk_bf16(v, v) & 0xffffu); }
__device__ __forceinline__ float wave_sum(float v) {
#pragma unroll
    for (int o = 1; o < 64; o <<= 1) v += __shfl_xor(v, o);
    return v;
}

struct Args {
    const float* x; const float* norm1_g; const float* w_in; const float* attn_norm_g; const float* lambda_re; const float* lambda_im; const float* log_step;
    const float* b_re; const float* b_im; const float* c_re; const float* c_im; const float* d_skip; const float* w_glu; const float* ssm_norm_g; const float* w_out;
    const float* norm2_g; const float* w_gate; const float* w_up; const float* w_down; const float* final_norm_g;
    float* out; unsigned char* ws;
};

__device__ __forceinline__ void transpose_item(const float* W, int N, bf16_t* WT, int ldt, int k0, int n0, int drow0, int dcol0, const float* gk, float* scr, int lane) {
#pragma unroll 8
    for (int i = 0; i < 32; ++i) { const int kk = 2 * i + (lane >> 5); float v = W[(size_t)(k0 + kk) * N + n0 + (lane & 31)]; if (gk) v *= gk[k0 + kk]; scr[kk * 33 + (lane & 31)] = v; }
    asm volatile("s_waitcnt lgkmcnt(0)" ::: "memory");
    const int c = lane & 7;
#pragma unroll
    for (int j = 0; j < 4; ++j) { const int n = (lane >> 3) + 8 * j; const float* s = scr + (8 * c) * 33 + n;
        u32x4 o; o.x = cvt_pk_bf16(s[0 * 33], s[1 * 33]); o.y = cvt_pk_bf16(s[2 * 33], s[3 * 33]); o.z = cvt_pk_bf16(s[4 * 33], s[5 * 33]); o.w = cvt_pk_bf16(s[6 * 33], s[7 * 33]);
        *(u32x4*)(WT + (size_t)(drow0 + n) * ldt + dcol0 + 8 * c) = o; }
    asm volatile("s_waitcnt lgkmcnt(0)" ::: "memory");
}

__device__ __forceinline__ void ssm_mats(const Args& A, int g, char* lds) {
    float2* lamp = (float2*)lds;
    float2* bbm = lamp + 17 * 64;
    float2* cm = bbm + 1024;
    float* Kt = (float*)(cm + 1024);
    float2* fb = (float2*)(Kt + 4096);
    const int tid = threadIdx.x;
    bf16_t* WstT = (bf16_t*)(A.ws + WS_SSM + (size_t)g * 262144); bf16_t* KinT = WstT + 128 * 256; bf16_t* WinT = KinT + 256 * 256;
    if (tid < 64) { const int p = tid; const float lr = A.lambda_re[g * 64 + p], li = A.lambda_im[g * 64 + p]; const float dt = expf(A.log_step[g]);
        const float mag = expf(lr * dt), ang = li * dt; const float lbr = mag * cosf(ang), lbi = mag * sinf(ang);
        const float den = lr * lr + li * li, nr = lbr - 1.0f; fb[p] = make_float2((nr * lr + lbi * li) / den, (lbi * lr - nr * li) / den);
        float2 pw = make_float2(1.f, 0.f); const float2 lb = make_float2(lbr, lbi);
        for (int k = 0; k <= 16; ++k) { lamp[k * 64 + p] = pw; pw = cmul(pw, lb); }
        ((float2*)(A.ws + WS_LAM16))[g * 64 + p] = lamp[16 * 64 + p]; }
    __syncthreads();
    for (int idx = tid; idx < 1024; idx += NTHR) { { const int p = idx >> 4, h = idx & 15; const float br = A.b_re[(size_t)(g * 64 + p) * 16 + h], bi = A.b_im[(size_t)(g * 64 + p) * 16 + h]; const float2 f = fb[p];
            bbm[idx] = make_float2(f.x * br - f.y * bi, f.x * bi + f.y * br); }
        { const int h = idx >> 6, p = idx & 63; cm[idx] = make_float2(A.c_re[(size_t)(g * 16 + h) * 64 + p], A.c_im[(size_t)(g * 16 + h) * 64 + p]); } }
    __syncthreads();
    for (int idx = tid; idx < 4096; idx += NTHR) { const int tau = idx >> 8, h = (idx >> 4) & 15, hp = idx & 15; float s = 0.f;
        for (int p = 0; p < 64; ++p) { const float2 cl = cmul(cm[h * 64 + p], lamp[tau * 64 + p]); const float2 bq = bbm[p * 16 + hp]; s += cl.x * bq.x - cl.y * bq.y; }
        if (tau == 0 && h == hp) s += A.d_skip[g * 16 + h];
        Kt[idx] = s; }
    __syncthreads();
    for (int ch = tid; ch < 8192; ch += NTHR) { const int n = ch >> 5, kc = ch & 31, t = n >> 4, h = n & 15, s = kc >> 1, hp0 = (kc & 1) * 8; float v[8];
#pragma unroll
        for (int e = 0; e < 8; ++e) v[e] = (s <= t) ? Kt[((t - s) * 16 + h) * 16 + hp0 + e] : 0.f;
        u32x4 o; o.x = cvt_pk_bf16(v[0], v[1]); o.y = cvt_pk_bf16(v[2], v[3]); o.z = cvt_pk_bf16(v[4], v[5]); o.w = cvt_pk_bf16(v[6], v[7]);
        *(u32x4*)(KinT + (size_t)n * 256 + kc * 8) = o; }
    for (int ch = tid; ch < 4096; ch += NTHR) { const int n = ch >> 5, kc = ch & 31, nb = n >> 5, j = n & 31, p = 32 * (nb >> 1) + j, part = nb & 1, s = kc >> 1, hp0 = (kc & 1) * 8; float v[8];
        const float2 l = lamp[(15 - s) * 64 + p];
#pragma unroll
        for (int e = 0; e < 8; ++e) { const float2 w = cmul(l, bbm[p * 16 + hp0 + e]); v[e] = part ? w.y : w.x; }
        u32x4 o; o.x = cvt_pk_bf16(v[0], v[1]); o.y = cvt_pk_bf16(v[2], v[3]); o.z = cvt_pk_bf16(v[4], v[5]); o.w = cvt_pk_bf16(v[6], v[7]);
        *(u32x4*)(WstT + (size_t)n * 256 + kc * 8) = o; }
    for (int ch = tid; ch < 4096; ch += NTHR) { const int n = ch >> 4, kc = ch & 15, t = n >> 4, h = n & 15; float v[8];
#pragma unroll
        for (int e = 0; e < 8; ++e) { const int k2 = kc * 8 + e, nb2 = k2 >> 5, j2 = k2 & 31, p = 32 * (nb2 >> 1) + j2, part = nb2 & 1;
            const float2 w = cmul(cm[h * 64 + p], lamp[(t + 1) * 64 + p]); v[e] = part ? -w.y : w.x; }
        u32x4 o; o.x = cvt_pk_bf16(v[0], v[1]); o.y = cvt_pk_bf16(v[2], v[3]); o.z = cvt_pk_bf16(v[4], v[5]); o.w = cvt_pk_bf16(v[6], v[7]);
        *(u32x4*)(WinT + (size_t)n * 128 + kc * 8) = o; }
    __syncthreads();
}

__device__ __forceinline__ void p0_prologue(const Args& A, char* lds, int G) {
    const int tid = threadIdx.x, lane = tid & 63, wave = tid >> 6;
    const int bx = blockIdx.x;
    for (int g = bx; g < NGRP; g += G) ssm_mats(A, g, lds);
    float* scr = (float*)(lds + wave * 16384);
    const int gw = bx * NWAVES + wave, NGW = G * NWAVES;
    bf16_t* Win_t = (bf16_t*)(A.ws + WS_WIN); bf16_t* Wglu_t = (bf16_t*)(A.ws + WS_WGLU); bf16_t* Wout_t = (bf16_t*)(A.ws + WS_WOUT);
    bf16_t* Wgu_t = (bf16_t*)(A.ws + WS_WGU); bf16_t* Wdn_t = (bf16_t*)(A.ws + WS_WDN);
    constexpr int I_IN = 16 * 64, I_GLU = 8 * 16, I_OUT = 16 * 32, I_G = 16 * 88, I_U = 16 * 88, I_D = 44 * 32;
    constexpr int NITEMS = I_IN + I_GLU + I_OUT + I_G + I_U + I_D;
    for (int it = gw; it < NITEMS; it += NGW) {
        int r = it;
        if (r < I_IN) { const int kb = r / 64, nb = r % 64, n0 = 32 * nb; const int drow0 = (n0 < 1024) ? n0 : (n0 < 1536 ? n0 + 512 : n0 - 512);
            transpose_item(A.w_in, 2048, Win_t, 1024, 64 * kb, n0, drow0, 64 * kb, nullptr, scr, lane); continue; } r -= I_IN;
        if (r < I_GLU) { const int kb = r / 16, nb = r % 16; transpose_item(A.w_glu, 512, Wglu_t, 512, 64 * kb, 32 * nb, 32 * nb, 64 * kb, nullptr, scr, lane); continue; } r -= I_GLU;
        if (r < I_OUT) { const int kb = r / 32, nb = r % 32, k0 = 64 * kb; const bool ssm = k0 >= 512;
            transpose_item(A.w_out, 1024, Wout_t, 1024, k0, 32 * nb, 32 * nb, ssm ? k0 - 512 : k0 + 512, ssm ? (A.ssm_norm_g - 512) : A.attn_norm_g, scr, lane); continue; } r -= I_OUT;
        if (r < I_G) { const int kb = r / 88, nb = r % 88, n0 = 32 * nb; transpose_item(A.w_gate, DFF, Wgu_t, 1024, 64 * kb, n0, 256 * (n0 / 128) + (n0 % 128), 64 * kb, A.norm2_g, scr, lane); continue; } r -= I_G;
        if (r < I_U) { const int kb = r / 88, nb = r % 88, n0 = 32 * nb; transpose_item(A.w_up, DFF, Wgu_t, 1024, 64 * kb, n0, 256 * (n0 / 128) + 128 + (n0 % 128), 64 * kb, A.norm2_g, scr, lane); continue; } r -= I_U;
        { const int kb = r / 32, nb = r % 32; transpose_item(A.w_down, 1024, Wdn_t, DFF, 64 * kb, 32 * nb, 32 * nb, 64 * kb, nullptr, scr, lane); }
    }
    bf16_t* XN = (bf16_t*)(A.ws + WS_XN);
    f32x4 gv[4];
#pragma unroll
    for (int j = 0; j < 4; ++j) gv[j] = ((const f32x4*)A.norm1_g)[lane + 64 * j];
    for (int m = gw; m < MTOK; m += NGW) {
        const f32x4* xr = (const f32x4*)(A.x + (size_t)m * DM) + lane; f32x4 v[4]; float s = 0.f;
#pragma unroll
        for (int j = 0; j < 4; ++j) { v[j] = xr[64 * j]; s += (v[j][0] * v[j][0] + v[j][1] * v[j][1]) + (v[j][2] * v[j][2] + v[j][3] * v[j][3]); }
        const float rs = 1.0f / sqrtf(wave_sum(s) * (1.0f / DM) + EPS);
        u32x2* o8 = (u32x2*)(XN + (size_t)m * DM) + lane;
#pragma unroll
        for (int j = 0; j < 4; ++j) { u32x2 w; w.x = cvt_pk_bf16(v[j][0] * rs * gv[j][0], v[j][1] * rs * gv[j][1]); w.y = cvt_pk_bf16(v[j][2] * rs * gv[j][2], v[j][3] * rs * gv[j][3]); o8[64 * j] = w; }
    }
}

__device__ __forceinline__ float gelu_tanh(float y) {
    const float u = 0.7978845608028654f * (y + 0.044715f * y * y * y);
    return y * __builtin_amdgcn_rcpf(1.0f + __builtin_amdgcn_exp2f(-2.0f * 1.4426950408889634f * u));
}
__device__ __forceinline__ void ssm_item(const Args& A, int b, int g, char* lds) {
    const int tid = threadIdx.x, lane = tid & 63, w = __builtin_amdgcn_readfirstlane(tid >> 6), j = lane & 31, hi = lane >> 5;
    float2* E = (float2*)lds;
    bf16_t* XS = (bf16_t*)(lds + 65536);
    float2* SEG = (float2*)(lds + 65536 + 69632);
    const bf16_t* PROJ = (const bf16_t*)(A.ws + WS_PROJ);
    const bf16_t* WstT = (const bf16_t*)(A.ws + WS_SSM + (size_t)g * 262144); const bf16_t* KinT = WstT + 128 * 256; const bf16_t* WinT = KinT + 256 * 256;
    const float2* LAM16 = (const float2*)(A.ws + WS_LAM16);
    bf16_t* YG = (bf16_t*)(A.ws + WS_YG);
    bf16x8 ua[16];
    { const bf16_t* up = PROJ + ((size_t)(b * SEQ + 16 * (32 * w + j))) * PROJ_LD + 1024 + g * 16 + 8 * hi;
#pragma unroll
      for (int tl = 0; tl < 16; ++tl) ua[tl] = *(const bf16x8*)(up + (size_t)tl * PROJ_LD); }
#pragma unroll 1
    for (int hp = 0; hp < 2; ++hp) {
        f32x16 are = {}, aim = {};
        const bf16_t* brp = WstT + (size_t)(64 * hp + j) * 256 + 8 * hi; const bf16_t* bip = brp + 32 * 256;
#pragma unroll
        for (int ks = 0; ks < 16; ++ks) { const bf16x8 br = *(const bf16x8*)(brp + 16 * ks), bi = *(const bf16x8*)(bip + 16 * ks);
            are = __builtin_amdgcn_mfma_f32_32x32x16_bf16(ua[ks], br, are, 0, 0, 0); aim = __builtin_amdgcn_mfma_f32_32x32x16_bf16(ua[ks], bi, aim, 0, 0, 0); }
#pragma unroll
        for (int r = 0; r < 16; ++r) E[(32 * w + crow(r, hi)) * 32 + j] = make_float2(are[r], aim[r]);
        __syncthreads();
        { const int seg = tid >> 5, pl = tid & 31; const float2 l16 = LAM16[g * 64 + 32 * hp + pl];
          float2 x = make_float2(0.f, 0.f);
          for (int i = 0; i < 16; ++i) { const float2 e = E[(16 * seg + i) * 32 + pl]; const float2 t = cmul(l16, x); x = make_float2(t.x + e.x, t.y + e.y); }
          SEG[seg * 32 + pl] = x;
          __syncthreads();
          float2 l256 = l16;
#pragma unroll
          for (int q = 0; q < 4; ++q) l256 = cmul(l256, l256);
          float2 xs = make_float2(0.f, 0.f);
          for (int s2 = 0; s2 < seg; ++s2) { const float2 e = SEG[s2 * 32 + pl]; const float2 t = cmul(l256, xs); xs = make_float2(t.x + e.x, t.y + e.y); }
          x = xs;
          for (int i = 0; i < 16; ++i) { const int c = 16 * seg + i; XS[c * 136 + 64 * hp + pl] = bf1(x.x); XS[c * 136 + 64 * hp + 32 + pl] = bf1(x.y);
              const float2 e = E[c * 32 + pl]; const float2 t = cmul(l16, x); x = make_float2(t.x + e.x, t.y + e.y); } }
        __syncthreads();
    }
#pragma unroll
    for (int nbh = 0; nbh < 2; ++nbh) {
        f32x16 acc[4]; acc[0] = f32x16{}; acc[1] = f32x16{}; acc[2] = f32x16{}; acc[3] = f32x16{};
        const bf16_t* kp = KinT + (size_t)(128 * nbh + j) * 256 + 8 * hi;
#pragma unroll
        for (int ks = 0; ks < 16; ++ks)
#pragma unroll
            for (int q = 0; q < 4; ++q) { if (ks <= 2 * (4 * nbh + q) + 1) {
                    const bf16x8 bv = *(const bf16x8*)(kp + (size_t)q * 32 * 256 + 16 * ks); acc[q] = __builtin_amdgcn_mfma_f32_32x32x16_bf16(ua[ks], bv, acc[q], 0, 0, 0); } }
        const bf16_t* wp = WinT + (size_t)(128 * nbh + j) * 128 + 8 * hi;
#pragma unroll
        for (int k2 = 0; k2 < 8; ++k2) { const bf16x8 av = *(const bf16x8*)(XS + (32 * w + j) * 136 + 16 * k2 + 8 * hi);
#pragma unroll
            for (int q = 0; q < 4; ++q) { const bf16x8 bv = *(const bf16x8*)(wp + (size_t)q * 32 * 128 + 16 * k2); acc[q] = __builtin_amdgcn_mfma_f32_32x32x16_bf16(av, bv, acc[q], 0, 0, 0); } }
#pragma unroll
        for (int q = 0; q < 4; ++q) { const int n = 128 * nbh + 32 * q + j, t = n >> 4, h = n & 15;
#pragma unroll
            for (int r = 0; r < 16; ++r) { const int c = 32 * w + crow(r, hi); const int tok = 16 * c + t;
                YG[(size_t)(b * SEQ + tok) * DSSM + g * 16 + h] = bf1(gelu_tanh(acc[q][r])); } }
    }
    __syncthreads();
}

constexpr float ATT_SC = 0.125f * 1.4426950408889634f;
constexpr float ATT_STOP = 160.0f;
__device__ __forceinline__ void attn_item(const Args& A, int b, int qt, char* lds) {
    const int tid = threadIdx.x, lane = tid & 63, h = __builtin_amdgcn_readfirstlane(tid >> 6), j = lane & 31, hi = lane >> 5;
    float* OST = (float*)lds + h * (32 * 68);
    float* PART = (float*)(lds + 69632);
    const bf16_t* PROJ = (const bf16_t*)(A.ws + WS_PROJ);
    const bf16_t* VT = (const bf16_t*)(A.ws + WS_VT);
    bf16_t* Z = (bf16_t*)(A.ws + WS_Z);
    const int q0 = 32 * qt; const size_t rowbase = (size_t)b * SEQ;
    bf16x8 qf[4];
    { const bf16_t* qp = PROJ + (rowbase + q0 + j) * PROJ_LD + h * 64 + 8 * hi;
#pragma unroll
      for (int d0 = 0; d0 < 4; ++d0) qf[d0] = *(const bf16x8*)(qp + 16 * d0); }
    const bf16_t* kbase = PROJ + rowbase * PROJ_LD + 512 + h * 64 + 8 * hi;
    const bf16_t* vbase = VT + (size_t)(h * 64 + j) * MTOK + rowbase + 4 * hi;
    f32x16 o0 = {}, o1 = {}; float R2 = 0.f;
    bf16x8 kf[4]; s16x4 va[2][2], vb[2][2];
#define LOADKV(kt_) do { const int k0_ = 32 * (kt_); const bf16_t* kp_ = kbase + (size_t)(k0_ + j) * PROJ_LD; \
        _Pragma("unroll") for (int d0 = 0; d0 < 4; ++d0) kf[d0] = *(const bf16x8*)(kp_ + 16 * d0); \
        _Pragma("unroll") for (int db = 0; db < 2; ++db) _Pragma("unroll") for (int ks = 0; ks < 2; ++ks) { const bf16_t* vp_ = vbase + (size_t)db * 32 * MTOK + k0_ + 16 * ks; \
            va[db][ks] = *(const s16x4*)(vp_); vb[db][ks] = *(const s16x4*)(vp_ + 8); } } while (0)
    LOADKV(qt);
    for (int kt = qt; kt >= 0; --kt) {
        f32x16 s = {};
#pragma unroll
        for (int d0 = 0; d0 < 4; ++d0) s = __builtin_amdgcn_mfma_f32_32x32x16_bf16(kf[d0], qf[d0], s, 0, 0, 0);
        bf16x8 vf[2][2];
#pragma unroll
        for (int db = 0; db < 2; ++db)
#pragma unroll
            for (int ks = 0; ks < 2; ++ks) vf[db][ks] = (bf16x8){va[db][ks][0], va[db][ks][1], va[db][ks][2], va[db][ks][3], vb[db][ks][0], vb[db][ks][1], vb[db][ks][2], vb[db][ks][3]};
        if (kt > 0) LOADKV(kt - 1);
        const bool diag = (kt == qt);
        float L[16], z2[16];
#pragma unroll
        for (int r = 0; r < 16; ++r) { const float z = s[r] * ATT_SC; const float e = __builtin_amdgcn_exp2f(-fabsf(z));
            const float l = fmaxf(z, 0.f) + __builtin_amdgcn_logf(1.0f + e);
            const bool msk = diag && (crow(r, hi) >= j); L[r] = msk ? 0.f : l; z2[r] = msk ? -1e30f : z; }
        float gs[4], pg[4];
#pragma unroll
        for (int g4 = 0; g4 < 4; ++g4) { gs[g4] = (L[4 * g4] + L[4 * g4 + 1]) + (L[4 * g4 + 2] + L[4 * g4 + 3]); pg[g4] = __shfl_xor(gs[g4], 32); }
        float T[4]; T[3] = 0.f; T[2] = gs[3] + pg[3]; T[1] = T[2] + (gs[2] + pg[2]); T[0] = T[1] + (gs[1] + pg[1]);
        const float total = T[0] + (gs[0] + pg[0]);
        float wv[16];
#pragma unroll
        for (int g4 = 0; g4 < 4; ++g4) { const float after = T[g4] + (hi == 0 ? pg[g4] : 0.f) + R2;
            const float s3 = after, s2 = s3 + L[4 * g4 + 3], s1 = s2 + L[4 * g4 + 2], s0 = s1 + L[4 * g4 + 1];
            wv[4 * g4 + 3] = __builtin_amdgcn_exp2f(z2[4 * g4 + 3] - L[4 * g4 + 3] - s3);
            wv[4 * g4 + 2] = __builtin_amdgcn_exp2f(z2[4 * g4 + 2] - L[4 * g4 + 2] - s2);
            wv[4 * g4 + 1] = __builtin_amdgcn_exp2f(z2[4 * g4 + 1] - L[4 * g4 + 1] - s1);
            wv[4 * g4 + 0] = __builtin_amdgcn_exp2f(z2[4 * g4 + 0] - L[4 * g4 + 0] - s0); }
        R2 += total;
        u32x4 p0, p1;
        p0.x = cvt_pk_bf16(wv[0], wv[1]); p0.y = cvt_pk_bf16(wv[2], wv[3]); p0.z = cvt_pk_bf16(wv[4], wv[5]); p0.w = cvt_pk_bf16(wv[6], wv[7]);
        p1.x = cvt_pk_bf16(wv[8], wv[9]); p1.y = cvt_pk_bf16(wv[10], wv[11]); p1.z = cvt_pk_bf16(wv[12], wv[13]); p1.w = cvt_pk_bf16(wv[14], wv[15]);
        const bf16x8 pa0 = __builtin_bit_cast(bf16x8, p0), pa1 = __builtin_bit_cast(bf16x8, p1);
        o0 = __builtin_amdgcn_mfma_f32_32x32x16_bf16(pa0, vf[0][0], o0, 0, 0, 0); o0 = __builtin_amdgcn_mfma_f32_32x32x16_bf16(pa1, vf[0][1], o0, 0, 0, 0);
        o1 = __builtin_amdgcn_mfma_f32_32x32x16_bf16(pa0, vf[1][0], o1, 0, 0, 0); o1 = __builtin_amdgcn_mfma_f32_32x32x16_bf16(pa1, vf[1][1], o1, 0, 0, 0);
        if (__all(R2 > ATT_STOP)) break;
    }
#undef LOADKV
#pragma unroll
    for (int r = 0; r < 16; ++r) { OST[crow(r, hi) * 68 + j] = o0[r]; OST[crow(r, hi) * 68 + 32 + j] = o1[r]; }
    asm volatile("s_waitcnt lgkmcnt(0)" ::: "memory");
    f32x4 ov[8]; float ss = 0.f;
#pragma unroll
    for (int e = 0; e < 8; ++e) { ov[e] = *(const f32x4*)(OST + j * 68 + 32 * hi + 4 * e); ss += (ov[e][0] * ov[e][0] + ov[e][1] * ov[e][1]) + (ov[e][2] * ov[e][2] + ov[e][3] * ov[e][3]); }
    PART[(h * 32 + j) * 2 + hi] = ss;
    __syncthreads();
    float tot = 0.f;
#pragma unroll
    for (int w2 = 0; w2 < 8; ++w2) { tot += PART[(w2 * 32 + j) * 2] + PART[(w2 * 32 + j) * 2 + 1]; }
    const float rs = 1.0f / sqrtf(tot * (1.0f / DATT) + EPS);
    bf16_t* zp = Z + (rowbase + q0 + j) * 1024 + 512 + h * 64 + 32 * hi;
#pragma unroll
    for (int e = 0; e < 4; ++e) { const f32x4 a = ov[2 * e] * rs, c = ov[2 * e + 1] * rs; u32x4 w;
        w.x = cvt_pk_bf16(a[0], a[1]); w.y = cvt_pk_bf16(a[2], a[3]); w.z = cvt_pk_bf16(c[0], c[1]); w.w = cvt_pk_bf16(c[2], c[3]); *(u32x4*)(zp + 8 * e) = w; }
    __syncthreads();
}

__global__ void __launch_bounds__(NTHR, 2) hymba_fwd(Args A) {
    extern __shared__ __attribute__((aligned(16))) unsigned char lds[];
    cg::grid_group grid = cg::this_grid();
    const int G = gridDim.x, bx = blockIdx.x;
    PG8_LAS unsigned char* lds3 = (PG8_LAS unsigned char*)lds;

#ifndef NO_P0
    p0_prologue(A, (char*)lds, G);
#endif
    grid.sync();

#ifndef NO_P1
    {
        pg8::Gemm g{(const bf16_t*)(A.ws + WS_XN), (const bf16_t*)(A.ws + WS_WIN), MTOK, 1536, DM}; pg8::StaticOrder S; S.init(MTOK, 1536, G, bx);
        pg8::EpiStore E{(bf16_t*)(A.ws + WS_PROJ), PROJ_LD};
        pg8::gemm_phase<pg8::EpiStore, pg8::StaticOrder, true, true, false>(lds3, g, S, E, nullptr, 0.f);
        pg8::Gemm g2{(const bf16_t*)(A.ws + WS_WIN) + (size_t)1536 * DM, (const bf16_t*)(A.ws + WS_XN), 512, MTOK, DM}; pg8::StaticOrder S2; S2.init(512, MTOK, G, bx);
        pg8::EpiStore E2{(bf16_t*)(A.ws + WS_VT), MTOK};
        pg8::gemm_phase<pg8::EpiStore, pg8::StaticOrder, true, true, false>(lds3, g2, S2, E2, nullptr, 0.f);
    }
#endif
    grid.sync();

#ifndef NO_SSM
    for (int it = bx; it < NB * NGRP; it += G) ssm_item(A, it >> 5, it & 31, (char*)lds);
#endif
#ifndef NO_ATT
    for (int it = bx; it < NB * (SEQ / 32); it += G) attn_item(A, it >> 7, it & 127, (char*)lds);
#endif
    grid.sync();

#ifndef NO_P3
    {
        pg8::Gemm g{(const bf16_t*)(A.ws + WS_YG), (const bf16_t*)(A.ws + WS_WGLU), MTOK, 512, 512}; pg8::StaticOrder S; S.init(MTOK, 512, G, bx);
        pg8::EpiGlu E{(const bf16_t*)(A.ws + WS_YG), (bf16_t*)(A.ws + WS_Z), (float*)(A.ws + WS_PART1)};
        pg8::gemm_phase<pg8::EpiGlu, pg8::StaticOrder, true, true, false>(lds3, g, S, E, nullptr, 0.f);
    }
#endif
    grid.sync();

#ifndef NO_P4
    {
        pg8::Gemm g{(const bf16_t*)(A.ws + WS_Z), (const bf16_t*)(A.ws + WS_WOUT), MTOK, DM, DM}; pg8::StaticOrder S; S.init(MTOK, DM, G, bx);
        pg8::EpiRes E{A.x, A.out, (bf16_t*)(A.ws + WS_XN), (float*)(A.ws + WS_PART2)};
        pg8::gemm_phase<pg8::EpiRes, pg8::StaticOrder, true, true, true>(lds3, g, S, E, (const float*)(A.ws + WS_PART1), EPS);
    }
#endif
    grid.sync();

#ifndef NO_P5
    {
        pg8::Gemm g{(const bf16_t*)(A.ws + WS_XN), (const bf16_t*)(A.ws + WS_WGU), MTOK, 2 * DFF, DM}; pg8::StaticOrder S; S.init(MTOK, 2 * DFF, G, bx);
        pg8::EpiGateUp E{(bf16_t*)(A.ws + WS_H), (const float*)(A.ws + WS_PART2), EPS};
        pg8::gemm_phase<pg8::EpiGateUp, pg8::StaticOrder, true, true, false>(lds3, g, S, E, nullptr, 0.f);
    }
#endif
    grid.sync();

#ifndef NO_P6
    {
        pg8::Gemm g{(const bf16_t*)(A.ws + WS_H), (const bf16_t*)(A.ws + WS_WDN), MTOK, DM, DFF}; pg8::StaticOrder S; S.init(MTOK, DM, G, bx);
        pg8::EpiRes E{A.out, A.out, nullptr, (float*)(A.ws + WS_PART3)};
        pg8::gemm_phase<pg8::EpiRes, pg8::StaticOrder, true, true, false>(lds3, g, S, E, nullptr, 0.f);
    }
#endif
    grid.sync();

    {
        int tid7 = threadIdx.x; asm volatile("" : "+v"(tid7));
        const int wave = tid7 >> 6, lane = tid7 & 63;
        const int gw = bx * NWAVES + wave, NGW = G * NWAVES;
        f32x4 gv[4];
#pragma unroll
        for (int j = 0; j < 4; ++j) gv[j] = ((const f32x4*)A.final_norm_g)[lane + 64 * j];
        const float* part = (const float*)(A.ws + WS_PART3);
        for (int m = gw; m < MTOK; m += NGW) {
            const f32x4* pp = (const f32x4*)(part + (size_t)m * 16); const f32x4 p0 = pp[0], p1 = pp[1], p2 = pp[2], p3 = pp[3];
            const float s = ((p0[0] + p0[1]) + (p0[2] + p0[3])) + ((p1[0] + p1[1]) + (p1[2] + p1[3])) + ((p2[0] + p2[1]) + (p2[2] + p2[3])) + ((p3[0] + p3[1]) + (p3[2] + p3[3]));
            const float rs = 1.0f / sqrtf(s * (1.0f / DM) + EPS);
            f32x4* xr = (f32x4*)(A.out + (size_t)m * DM) + lane;
#pragma unroll
            for (int j = 0; j < 4; ++j) { const f32x4 v = xr[64 * j]; xr[64 * j] = v * rs * gv[j]; }
        }
    }
}

extern "C" void kernel_launch(void* const* d_in, const int* in_sizes, int n_in, void* d_out, int out_size, void* d_ws, size_t ws_size, hipStream_t stream) {
    static int grid = 0;
    if (grid == 0) {
        if (n_in != 20 || in_sizes[0] != MTOK * DM || out_size != MTOK * DM || ws_size < WS_END) { fprintf(stderr, "kernel_launch: unexpected problem shape / workspace (%d inputs, ws %zu)\n", n_in, ws_size); grid = -1; return; }
        int dev = 0, cus = 0, per_cu = 0;
        if (hipGetDevice(&dev) != hipSuccess || hipDeviceGetAttribute(&cus, hipDeviceAttributeMultiprocessorCount, dev) != hipSuccess) { grid = -1; return; }
        if (hipFuncSetAttribute((const void*)hymba_fwd, hipFuncAttributeMaxDynamicSharedMemorySize, LDS_BYTES) != hipSuccess) { fprintf(stderr, "kernel_launch: hipFuncSetAttribute failed\n"); grid = -1; return; }
        if (hipOccupancyMaxActiveBlocksPerMultiprocessor(&per_cu, (const void*)hymba_fwd, NTHR, LDS_BYTES) != hipSuccess || per_cu < 1) { fprintf(stderr, "kernel_launch: occupancy query says %d\n", per_cu); per_cu = 1; }
        (void)hipGetLastError();
        grid = cus * 1;
    }
    if (grid < 0) return;
    Args a{};
    const float** f = (const float**)&a;
    for (int i = 0; i < 20; ++i) f[i] = (const float*)d_in[i];
    a.out = (float*)d_out; a.ws = (unsigned char*)d_ws;
    void* args[] = {&a};
    hipError_t e = hipLaunchCooperativeKernel((const void*)hymba_fwd, dim3(grid), dim3(NTHR), args, LDS_BYTES, stream);
    if (e != hipSuccess) fprintf(stderr, "cooperative launch failed: %s (grid %d)\n", hipGetErrorString(e), grid);
}
```

```cpp
#include <hip/hip_runtime.h>
#include <hip/hip_cooperative_groups.h>
#include <cstdio>
#include <cstdint>
namespace cg = cooperative_groups;

namespace pg8 {
#define PG8_LAS __attribute__((address_space(3)))
typedef unsigned short bf16_t;
typedef short bf16x8 __attribute__((ext_vector_type(8)));
typedef float f32x4 __attribute__((ext_vector_type(4)));
typedef float f32x2 __attribute__((ext_vector_type(2)));
typedef unsigned u32x4 __attribute__((ext_vector_type(4)));
typedef unsigned u32x2 __attribute__((ext_vector_type(2)));
constexpr int BM = 256, BK = 64, HALF = 128, HTB = HALF * BK * 2, STAGE_BYTES = 8 * HTB, NXCD = 8, WGM = 8;

__host__ __device__ __forceinline__ int lds_byte(int r, int c) { const int st = (r >> 4) * 2 + (c >> 5), rr = r & 15, cc = c & 31, ob = rr * 64 + cc * 2; return st * 1024 + (ob ^ (((ob >> 9) & 1) << 5)); }
__host__ __device__ __forceinline__ void stage_rc(int b, int& R, int& C) { const int st = b / 1024, sb = b % 1024, swz = sb ^ (((sb >> 9) & 1) << 5); R = (st >> 1) * 16 + swz / 64; C = (st & 1) * 32 + (swz % 64) / 2; }
__host__ __device__ __forceinline__ int perm32(int rho) { const int n = rho >> 4, i = rho & 15; return 8 * (i >> 2) + 4 * n + (i & 3); }

struct Unit { int pm, pn; };
struct Gemm { const bf16_t* A; const bf16_t* Bt; int M, N, K; };

struct StaticOrder {
    int nM, nN, nwg, G, c;
    __host__ __device__ void init(int M, int N, int G_, int c_) { nM = M / BM; nN = N / BM; nwg = nM * nN; G = G_; c = c_; }
    __host__ __device__ bool next(int i, Unit& u) const {
        const long L = (long)i * G + c; if (L >= nwg) return false;
        int wgid = (int)L; { const int q = nwg / NXCD, r = nwg % NXCD, xcd = wgid % NXCD, off = wgid / NXCD; wgid = (xcd < r ? xcd * (q + 1) : r * (q + 1) + (xcd - r) * q) + off; }
        const int nig = WGM * nN, gid = wgid / nig, fm = gid * WGM, gsz = (nM - fm) < WGM ? (nM - fm) : WGM;
        u.pm = fm + ((wgid % nig) % gsz); u.pn = (wgid % nig) / gsz; return true;
    }
    __device__ __forceinline__ void a_ready(const Unit&) const {}
    __device__ __forceinline__ void done(const Unit&) const {}
};

__device__ __forceinline__ unsigned cvt_pk_bf16(float lo, float hi) { unsigned r; asm volatile("v_cvt_pk_bf16_f32 %0, %1, %2" : "=v"(r) : "v"(lo), "v"(hi)); return r; }
__device__ __forceinline__ float bf_lo(unsigned w) { return __uint_as_float(w << 16); }
__device__ __forceinline__ float bf_hi(unsigned w) { return __uint_as_float(w & 0xffff0000u); }

struct EpiStore {
    static constexpr bool PERM = true;
    bf16_t* O; int ldc;
    __device__ __forceinline__ void operator()(const f32x4 (&acc)[2][2][4][2], const Unit& u, int wr, int wc, int fr, int fq) const {
        asm volatile("" : "+v"(fr), "+v"(fq));
        const int row0 = u.pm * BM + wr * 64 + fr, col0 = u.pn * BM + wc * 32 + 8 * fq;
#pragma unroll
        for (int ai = 0; ai < 2; ++ai)
#pragma unroll
            for (int m = 0; m < 4; ++m) { bf16_t* rowp = O + (size_t)(row0 + ai * HALF + m * 16) * ldc + col0;
#pragma unroll
                for (int bj = 0; bj < 2; ++bj) { const f32x4 v0 = acc[ai][bj][m][0], v1 = acc[ai][bj][m][1];
                    u32x4 w; w.x = cvt_pk_bf16(v0[0], v0[1]); w.y = cvt_pk_bf16(v0[2], v0[3]); w.z = cvt_pk_bf16(v1[0], v1[1]); w.w = cvt_pk_bf16(v1[2], v1[3]);
                    *(u32x4*)(rowp + bj * HALF) = w; } }
    }
};
__device__ __forceinline__ float sigmoidf_fast(float a) { return __builtin_amdgcn_rcpf(1.0f + __builtin_amdgcn_exp2f(-1.4426950408889634f * a)); }
struct EpiGlu {
    static constexpr bool PERM = true;
    const bf16_t* Y; bf16_t* Z; float* part;
    __device__ __forceinline__ void operator()(const f32x4 (&acc)[2][2][4][2], const Unit& u, int wr, int wc, int fr, int fq) const {
        asm volatile("" : "+v"(fr), "+v"(fq));
        const int row0 = u.pm * BM + wr * 64 + fr, col0 = u.pn * BM + wc * 32 + 8 * fq;
#pragma unroll
        for (int ai = 0; ai < 2; ++ai)
#pragma unroll
            for (int m = 0; m < 4; ++m) { const int row = row0 + ai * HALF + m * 16; float ss = 0.f;
#pragma unroll
                for (int bj = 0; bj < 2; ++bj) { const int col = col0 + bj * HALF;
                    const u32x4 yv = *(const u32x4*)(Y + (size_t)row * 512 + col);
                    const f32x4 a0 = acc[ai][bj][m][0], a1 = acc[ai][bj][m][1];
                    float v[8];
                    v[0] = bf_lo(yv.x) * sigmoidf_fast(a0[0]); v[1] = bf_hi(yv.x) * sigmoidf_fast(a0[1]);
                    v[2] = bf_lo(yv.y) * sigmoidf_fast(a0[2]); v[3] = bf_hi(yv.y) * sigmoidf_fast(a0[3]);
                    v[4] = bf_lo(yv.z) * sigmoidf_fast(a1[0]); v[5] = bf_hi(yv.z) * sigmoidf_fast(a1[1]);
                    v[6] = bf_lo(yv.w) * sigmoidf_fast(a1[2]); v[7] = bf_hi(yv.w) * sigmoidf_fast(a1[3]);
#pragma unroll
                    for (int e = 0; e < 8; ++e) ss += v[e] * v[e];
                    u32x4 w; w.x = cvt_pk_bf16(v[0], v[1]); w.y = cvt_pk_bf16(v[2], v[3]); w.z = cvt_pk_bf16(v[4], v[5]); w.w = cvt_pk_bf16(v[6], v[7]);
                    *(u32x4*)(Z + (size_t)row * 1024 + col) = w; }
                ss += __shfl_xor(ss, 16); ss += __shfl_xor(ss, 32);
                if (fq == 0) part[(size_t)row * 8 + u.pn * 4 + wc] = ss; asm volatile("" ::: "memory"); }
    }
};
struct EpiRes {
    static constexpr bool PERM = false;
    const float* base; float* out; bf16_t* xb; float* part;
    __device__ __forceinline__ void operator()(const f32x4 (&acc)[2][2][4][2], const Unit& u, int wr, int wc, int fr, int fq) const {
        asm volatile("" : "+v"(fr), "+v"(fq));
        const int row0 = u.pm * BM + wr * 64 + fr, col0 = u.pn * BM + wc * 32 + 4 * fq;
#pragma unroll
        for (int ai = 0; ai < 2; ++ai)
#pragma unroll
            for (int m = 0; m < 4; ++m) { const int row = row0 + ai * HALF + m * 16; float ss = 0.f; const size_t off = (size_t)row * 1024 + col0;
#pragma unroll
                for (int bj = 0; bj < 2; ++bj)
#pragma unroll
                    for (int n = 0; n < 2; ++n) { const size_t o2 = off + bj * HALF + n * 16;
                        const f32x4 b = *(const f32x4*)(base + o2); const f32x4 v = b + acc[ai][bj][m][n];
                        *(f32x4*)(out + o2) = v; ss += (v[0] * v[0] + v[1] * v[1]) + (v[2] * v[2] + v[3] * v[3]);
                        if (xb) { u32x2 w; w.x = cvt_pk_bf16(v[0], v[1]); w.y = cvt_pk_bf16(v[2], v[3]); *(u32x2*)(xb + o2) = w; } }
                ss += __shfl_xor(ss, 16); ss += __shfl_xor(ss, 32);
                if (fq == 0) part[(size_t)row * 16 + u.pn * 4 + wc] = ss; asm volatile("" ::: "memory"); }
    }
};
struct EpiGateUp {
    static constexpr bool PERM = true;
    bf16_t* H; const float* part; float eps;
    __device__ __forceinline__ void operator()(const f32x4 (&acc)[2][2][4][2], const Unit& u, int wr, int wc, int fr, int fq) const {
        asm volatile("" : "+v"(fr), "+v"(fq));
        const int row0 = u.pm * BM + wr * 64 + fr, col0 = u.pn * HALF + wc * 32 + 8 * fq;
#pragma unroll
        for (int ai = 0; ai < 2; ++ai)
#pragma unroll
            for (int m = 0; m < 4; ++m) { const int row = row0 + ai * HALF + m * 16;
                const f32x4* pp = (const f32x4*)(part + (size_t)row * 16); const f32x4 p0 = pp[0], p1 = pp[1], p2 = pp[2], p3 = pp[3];
                const float s = ((p0[0] + p0[1]) + (p0[2] + p0[3])) + ((p1[0] + p1[1]) + (p1[2] + p1[3])) + ((p2[0] + p2[1]) + (p2[2] + p2[3])) + ((p3[0] + p3[1]) + (p3[2] + p3[3]));
                const float rs = 1.0f / sqrtf(s * (1.0f / 1024.0f) + eps);
                float v[8];
#pragma unroll
                for (int n = 0; n < 2; ++n)
#pragma unroll
                    for (int e = 0; e < 4; ++e) { const float g = acc[ai][0][m][n][e] * rs, up = acc[ai][1][m][n][e] * rs; v[n * 4 + e] = g * sigmoidf_fast(g) * up; }
                u32x4 w; w.x = cvt_pk_bf16(v[0], v[1]); w.y = cvt_pk_bf16(v[2], v[3]); w.z = cvt_pk_bf16(v[4], v[5]); w.w = cvt_pk_bf16(v[6], v[7]);
                *(u32x4*)(H + (size_t)row * 2816 + col0) = w; if (m & 1) asm volatile("" ::: "memory"); }
    }
};

template <class Epi, class Sched, bool ALIGN_EPI, bool SP2, bool MID>
__device__ __forceinline__ void gemm_phase(PG8_LAS unsigned char* lds, const Gemm g, const Sched& S, const Epi& E, const float* midp, float mid_eps) {
    int tid = threadIdx.x; asm volatile("" : "+v"(tid));
    const int wid = __builtin_amdgcn_readfirstlane(tid >> 6), lane = tid & 63, wr = wid >> 2, wc = wid & 3, fr = lane & 15, fq = lane >> 4;
    const int K = g.K, nt = K / BK;
    unsigned voffA[2], voffB[2];
#pragma unroll
    for (int i = 0; i < 2; ++i) { int R, C; stage_rc(tid * 16 + i * 8192, R, C); const int Rb = Epi::PERM ? ((R & ~31) + perm32(R & 31)) : R;
        voffA[i] = (unsigned)(R * K + C) * 2u; voffB[i] = (unsigned)(Rb * K + C) * 2u; }
    const size_t kstep = (size_t)(BK * 2);
    const size_t hstep = (size_t)HALF * K * 2;
    const size_t tstep = 2 * hstep;
    const unsigned ldsw = (unsigned)wid * 1024u;
    const int aoff = lds_byte(wr * 64 + fr, fq * 8), boff = lds_byte(wc * 32 + fr, fq * 8);
#define PG8_SA(b, h) (((b) * 2 + (h)) * HTB)
#define PG8_SB(b, h) ((4 + (b) * 2 + (h)) * HTB)
#define PG8_STAGE(bufoff, gbase, voff) do { _Pragma("unroll") for (int _i = 0; _i < 2; ++_i) \
        __builtin_amdgcn_global_load_lds((const unsigned*)((const char*)(gbase) + (voff)[_i]), (PG8_LAS unsigned*)(lds + (bufoff) + ldsw + _i * 8192), 16, 0, 0); } while (0)
#define PG8_LDA(dst, b, h) do { _Pragma("unroll") for (int m = 0; m < 4; ++m) _Pragma("unroll") for (int k = 0; k < 2; ++k) dst[m][k] = *(const PG8_LAS bf16x8*)(lds + PG8_SA(b, h) + aoff + m * 2048 + k * 1024); } while (0)
#define PG8_LDB(dst, b, h) do { _Pragma("unroll") for (int n = 0; n < 2; ++n) _Pragma("unroll") for (int k = 0; k < 2; ++k) dst[n][k] = *(const PG8_LAS bf16x8*)(lds + PG8_SB(b, h) + boff + n * 2048 + k * 1024); } while (0)
#define PG8_MMA(ai, bj, At, Bt) do { __builtin_amdgcn_s_setprio(1); _Pragma("unroll") for (int m = 0; m < 4; ++m) _Pragma("unroll") for (int n = 0; n < 2; ++n) _Pragma("unroll") for (int k = 0; k < 2; ++k) \
        acc[ai][bj][m][n] = __builtin_amdgcn_mfma_f32_16x16x32_bf16(Bt[n][k], At[m][k], acc[ai][bj][m][n], 0, 0, 0); __builtin_amdgcn_s_setprio(0); } while (0)
#define PG8_WAIT_V(n) asm volatile("s_waitcnt vmcnt(" #n ")" ::: "memory")
#define PG8_WAIT_L(n) asm volatile("s_waitcnt lgkmcnt(" #n ")" ::: "memory")
#define PG8_BAR __builtin_amdgcn_s_barrier()
#define PG8_SCHED __builtin_amdgcn_sched_barrier(0)
    Unit cur, nxt; int ui = 0;
    if (!S.next(0, cur)) return;
    f32x4 acc[2][2][4][2];
#pragma unroll
    for (int a = 0; a < 2; ++a)
#pragma unroll
        for (int b = 0; b < 2; ++b)
#pragma unroll
            for (int m = 0; m < 4; ++m)
#pragma unroll
                for (int n = 0; n < 2; ++n) acc[a][b][m][n] = (f32x4){0.f, 0.f, 0.f, 0.f};
    bf16x8 At[4][2], B0[2][2], B1[2][2];
    const char* cA = (const char*)g.A + (size_t)cur.pm * tstep; const char* cB = (const char*)g.Bt + (size_t)cur.pn * tstep;
    if constexpr (SP2) {
        PG8_STAGE(PG8_SB(0, 0), cB, voffB); PG8_STAGE(PG8_SB(0, 1), cB + hstep, voffB); PG8_STAGE(PG8_SA(0, 0), cA, voffA); PG8_STAGE(PG8_SA(0, 1), cA + hstep, voffA);
        if (wr == 1) PG8_BAR;
        PG8_WAIT_V(2); PG8_BAR;
        PG8_STAGE(PG8_SB(1, 0), cB + kstep, voffB); PG8_STAGE(PG8_SA(1, 0), cA + kstep, voffA); PG8_STAGE(PG8_SB(1, 1), cB + hstep + kstep, voffB);
        PG8_WAIT_V(6); PG8_BAR;
    } else {
        PG8_STAGE(PG8_SB(0, 0), cB, voffB); PG8_STAGE(PG8_SA(0, 0), cA, voffA); PG8_STAGE(PG8_SB(0, 1), cB + hstep, voffB); PG8_STAGE(PG8_SA(0, 1), cA + hstep, voffA);
        if (wr == 1) PG8_BAR;
        PG8_WAIT_V(4); PG8_BAR;
        PG8_STAGE(PG8_SB(1, 0), cB + kstep, voffB); PG8_STAGE(PG8_SA(1, 0), cA + kstep, voffA); PG8_STAGE(PG8_SB(1, 1), cB + hstep + kstep, voffB);
        PG8_WAIT_V(6); PG8_BAR;
    }
    for (;;) {
        const bool has_next = S.next(ui + 1, nxt);
        const char* nA = has_next ? (const char*)g.A + (size_t)nxt.pm * tstep : cA; const char* nB = has_next ? (const char*)g.Bt + (size_t)nxt.pn * tstep : cB;
        for (int t = 0; t < nt; t += 2) {
            const bool last = (t == nt - 2);
            const char* a1 = cA + (size_t)(t + 1) * kstep;
            const char* a2 = last ? nA : cA + (size_t)(t + 2) * kstep; const char* b2 = last ? nB : cB + (size_t)(t + 2) * kstep;
            const char* a3 = a2 + kstep; const char* b3 = b2 + kstep;
            if constexpr (MID) {
                if (t == (nt >> 1)) {
                    PG8_SCHED;
#pragma unroll
                    for (int ai = 0; ai < 2; ++ai)
#pragma unroll
                        for (int m = 0; m < 4; ++m) { const int row = cur.pm * BM + ai * HALF + wr * 64 + m * 16 + fr;
                            const f32x4 p0 = *(const f32x4*)(midp + (size_t)row * 8), p1 = *(const f32x4*)(midp + (size_t)row * 8 + 4);
                            const float s = ((p0[0] + p0[1]) + (p0[2] + p0[3])) + ((p1[0] + p1[1]) + (p1[2] + p1[3]));
                            const float rs = 1.0f / sqrtf(s * (1.0f / 512.0f) + mid_eps);
#pragma unroll
                            for (int bj = 0; bj < 2; ++bj)
#pragma unroll
                                for (int n = 0; n < 2; ++n) acc[ai][bj][m][n] = acc[ai][bj][m][n] * rs; asm volatile("" ::: "memory"); }
                    PG8_WAIT_V(0);
                    PG8_SCHED;
                }
            }
            if constexpr (SP2) {
            PG8_LDB(B0, 0, 0); PG8_LDB(B1, 0, 1); PG8_SCHED; PG8_LDA(At, 0, 0); PG8_STAGE(PG8_SA(1, 1), a1 + hstep, voffA);
            PG8_WAIT_V(8); PG8_WAIT_L(0); PG8_BAR; PG8_MMA(0, 0, At, B0); PG8_MMA(0, 1, At, B1); PG8_BAR; PG8_SCHED;
            PG8_LDA(At, 0, 1); PG8_STAGE(PG8_SB(0, 0), b2, voffB); PG8_STAGE(PG8_SB(0, 1), b2 + hstep, voffB); PG8_STAGE(PG8_SA(0, 0), a2, voffA);
            PG8_WAIT_V(8); PG8_WAIT_L(0); PG8_BAR; PG8_MMA(1, 0, At, B0); PG8_MMA(1, 1, At, B1); PG8_BAR; PG8_SCHED;
            PG8_LDB(B0, 1, 0); PG8_LDB(B1, 1, 1); PG8_SCHED; PG8_LDA(At, 1, 0); PG8_STAGE(PG8_SA(0, 1), a2 + hstep, voffA);
            PG8_WAIT_V(8); PG8_WAIT_L(0); PG8_BAR; PG8_MMA(0, 0, At, B0); PG8_MMA(0, 1, At, B1); PG8_BAR; PG8_SCHED;
            PG8_LDA(At, 1, 1); PG8_STAGE(PG8_SB(1, 0), b3, voffB); PG8_STAGE(PG8_SB(1, 1), b3 + hstep, voffB); PG8_STAGE(PG8_SA(1, 0), a3, voffA);
            PG8_WAIT_V(8); PG8_WAIT_L(0); PG8_BAR; PG8_MMA(1, 0, At, B0); PG8_MMA(1, 1, At, B1); PG8_BAR; PG8_SCHED;
            } else {
            PG8_LDB(B0, 0, 0); PG8_SCHED; PG8_LDA(At, 0, 0); PG8_STAGE(PG8_SA(1, 1), a1 + hstep, voffA);
            PG8_WAIT_L(8); PG8_BAR; PG8_WAIT_L(0); PG8_MMA(0, 0, At, B0); PG8_BAR; PG8_SCHED;
            PG8_LDB(B1, 0, 1); PG8_STAGE(PG8_SB(0, 0), b2, voffB);
            PG8_BAR; PG8_WAIT_L(0); PG8_MMA(0, 1, At, B1); PG8_BAR;
            PG8_LDA(At, 0, 1); PG8_STAGE(PG8_SA(0, 0), a2, voffA);
            PG8_BAR; PG8_WAIT_L(0); PG8_MMA(1, 0, At, B0); PG8_BAR; PG8_SCHED;
            PG8_STAGE(PG8_SB(0, 1), b2 + hstep, voffB);
            PG8_WAIT_V(6); PG8_BAR; PG8_MMA(1, 1, At, B1); PG8_BAR;
            PG8_LDB(B0, 1, 0); PG8_SCHED; PG8_LDA(At, 1, 0); PG8_STAGE(PG8_SA(0, 1), a2 + hstep, voffA);
            PG8_WAIT_L(8); PG8_BAR; PG8_WAIT_L(0); PG8_MMA(0, 0, At, B0); PG8_BAR; PG8_SCHED;
            PG8_LDB(B1, 1, 1); PG8_STAGE(PG8_SB(1, 0), b3, voffB);
            PG8_BAR; PG8_WAIT_L(0); PG8_MMA(0, 1, At, B1); PG8_BAR;
            PG8_LDA(At, 1, 1); PG8_STAGE(PG8_SA(1, 0), a3, voffA);
            PG8_BAR; PG8_WAIT_L(0); PG8_MMA(1, 0, At, B0); PG8_BAR; PG8_SCHED;
            PG8_STAGE(PG8_SB(1, 1), b3 + hstep, voffB);
            PG8_WAIT_V(6); PG8_BAR; PG8_MMA(1, 1, At, B1); PG8_BAR;
            }
        }
        if constexpr (ALIGN_EPI) { if (wr == 0) PG8_BAR; }
        E(acc, cur, wr, wc, fr, fq);
        if (!has_next) break;
#pragma unroll
        for (int a = 0; a < 2; ++a)
#pragma unroll
            for (int b = 0; b < 2; ++b)
#pragma unroll
                for (int m = 0; m < 4; ++m)
#pragma unroll
                    for (int n = 0; n < 2; ++n) acc[a][b][m][n] = (f32x4){0.f, 0.f, 0.f, 0.f};
        cur = nxt; cA = nA; cB = nB; ++ui;
        if constexpr (ALIGN_EPI) { if (wr == 1) PG8_BAR; }
    }
    PG8_WAIT_V(0);
    if constexpr (!ALIGN_EPI) { if (wr == 0) PG8_BAR; }
    PG8_BAR;
#undef PG8_SA
#undef PG8_SB
#undef PG8_STAGE
#undef PG8_LDA
#undef PG8_LDB
#undef PG8_MMA
#undef PG8_WAIT_V
#undef PG8_WAIT_L
#undef PG8_BAR
#undef PG8_SCHED
}
}

using pg8::bf16_t; using pg8::bf16x8; using pg8::f32x4; using pg8::u32x4; using pg8::u32x2; using pg8::cvt_pk_bf16;
typedef float f32x16 __attribute__((ext_vector_type(16)));
typedef short s16x4 __attribute__((ext_vector_type(4)));
constexpr int NB = 8, SEQ = 4096, DM = 1024, MTOK = NB * SEQ;
constexpr int NHEAD = 8, HD = 64, DATT = 512, DSSM = 512, NGRP = 32, GCH = 16, NST = 64, DFF = 2816;
constexpr int PROJ_LD = 1536;
constexpr float EPS = 1e-6f;
constexpr int NWAVES = 8, NTHR = 512;
constexpr int LDS_BYTES = 147456;
constexpr int MISC_OFF = 147456 - 512;

constexpr size_t MiB = 1u << 20;
constexpr size_t WS_CTL = 0, CTL_ZERO_BYTES = 65536;
constexpr int CW_BAR = 4096;
constexpr size_t WS_WIN = 1 * MiB;
constexpr size_t WS_WGLU = 5 * MiB;
constexpr size_t WS_WOUT = 6 * MiB;
constexpr size_t WS_WGU = 8 * MiB;
constexpr size_t WS_WDN = 20 * MiB;
constexpr size_t WS_SSM = 26 * MiB;
constexpr size_t WS_LAM16 = 34 * MiB;
constexpr size_t WS_PART1 = 35 * MiB;
constexpr size_t WS_PART2 = 36 * MiB;
constexpr size_t WS_PART3 = 38 * MiB;
constexpr size_t WS_XN = 48 * MiB;
constexpr size_t WS_Z = 112 * MiB;
constexpr size_t WS_VT = 176 * MiB;
constexpr size_t WS_PROJ = 208 * MiB;
constexpr size_t WS_YG = 304 * MiB;
constexpr size_t WS_H = 176 * MiB;
constexpr size_t WS_END = 352 * MiB;

__device__ __forceinline__ int crow(int r, int hi) { return (r & 3) + 8 * (r >> 2) + 4 * hi; }
__device__ __forceinline__ float2 cmul(float2 a, float2 b) { return make_float2(a.x * b.x - a.y * b.y, a.x * b.y + a.y * b.x); }
__device__ __forceinline__ unsigned short bf1(float v) { return (unsigned short)(cvt_pk_bf16(v, v) & 0xffffu); }
__device__ __forceinline__ float wave_sum(float v) {
#pragma unroll
    for (int o = 1; o < 64; o <<= 1) v += __shfl_xor(v, o);
    return v;
}

struct Args {
    const float* x; const float* norm1_g; const float* w_in; const float* attn_norm_g; const float* lambda_re; const float* lambda_im; const float* log_step;
    const float* b_re; const float* b_im; const float* c_re; const float* c_im; const float* d_skip; const float* w_glu; const float* ssm_norm_g; const float* w_out;
    const float* norm2_g; const float* w_gate; const float* w_up; const float* w_down; const float* final_norm_g;
    float* out; unsigned char* ws;
};

__device__ __forceinline__ void transpose_item(const float* W, int N, bf16_t* WT, int ldt, int k0, int n0, int drow0, int dcol0, const float* gk, float* scr, int lane) {
#pragma unroll 8
    for (int i = 0; i < 32; ++i) { const int kk = 2 * i + (lane >> 5); float v = W[(size_t)(k0 + kk) * N + n0 + (lane & 31)]; if (gk) v *= gk[k0 + kk]; scr[kk * 33 + (lane & 31)] = v; }
    asm volatile("s_waitcnt lgkmcnt(0)" ::: "memory");
    const int c = lane & 7;
#pragma unroll
    for (int j = 0; j < 4; ++j) { const int n = (lane >> 3) + 8 * j; const float* s = scr + (8 * c) * 33 + n;
        u32x4 o; o.x = cvt_pk_bf16(s[0 * 33], s[1 * 33]); o.y = cvt_pk_bf16(s[2 * 33], s[3 * 33]); o.z = cvt_pk_bf16(s[4 * 33], s[5 * 33]); o.w = cvt_pk_bf16(s[6 * 33], s[7 * 33]);
        *(u32x4*)(WT + (size_t)(drow0 + n) * ldt + dcol0 + 8 * c) = o; }
    asm volatile("s_waitcnt lgkmcnt(0)" ::: "memory");
}

__device__ __forceinline__ void ssm_mats(const Args& A, int g, char* lds) {
    float2* lamp = (float2*)lds;
    float2* bbm = lamp + 17 * 64;
    float2* cm = bbm + 1024;
    float* Kt = (float*)(cm + 1024);
    float2* fb = (float2*)(Kt + 4096);
    const int tid = threadIdx.x;
    bf16_t* WstT = (bf16_t*)(A.ws + WS_SSM + (size_t)g * 262144); bf16_t* KinT = WstT + 128 * 256; bf16_t* WinT = KinT + 256 * 256;
    if (tid < 64) { const int p = tid; const float lr = A.lambda_re[g * 64 + p], li = A.lambda_im[g * 64 + p]; const float dt = expf(A.log_step[g]);
        const float mag = expf(lr * dt), ang = li * dt; const float lbr = mag * cosf(ang), lbi = mag * sinf(ang);
        const float den = lr * lr + li * li, nr = lbr - 1.0f; fb[p] = make_float2((nr * lr + lbi * li) / den, (lbi * lr - nr * li) / den);
        float2 pw = make_float2(1.f, 0.f); const float2 lb = make_float2(lbr, lbi);
        for (int k = 0; k <= 16; ++k) { lamp[k * 64 + p] = pw; pw = cmul(pw, lb); }
        ((float2*)(A.ws + WS_LAM16))[g * 64 + p] = lamp[16 * 64 + p]; }
    __syncthreads();
    for (int idx = tid; idx < 1024; idx += NTHR) { { const int p = idx >> 4, h = idx & 15; const float br = A.b_re[(size_t)(g * 64 + p) * 16 + h], bi = A.b_im[(size_t)(g * 64 + p) * 16 + h]; const float2 f = fb[p];
            bbm[idx] = make_float2(f.x * br - f.y * bi, f.x * bi + f.y * br); }
        { const int h = idx >> 6, p = idx & 63; cm[idx] = make_float2(A.c_re[(size_t)(g * 16 + h) * 64 + p], A.c_im[(size_t)(g * 16 + h) * 64 + p]); } }
    __syncthreads();
    for (int idx = tid; idx < 4096; idx += NTHR) { const int tau = idx >> 8, h = (idx >> 4) & 15, hp = idx & 15; float s = 0.f;
        for (int p = 0; p < 64; ++p) { const float2 cl = cmul(cm[h * 64 + p], lamp[tau * 64 + p]); const float2 bq = bbm[p * 16 + hp]; s += cl.x * bq.x - cl.y * bq.y; }
        if (tau == 0 && h == hp) s += A.d_skip[g * 16 + h];
        Kt[idx] = s; }
    __syncthreads();
    for (int ch = tid; ch < 8192; ch += NTHR) { const int n = ch >> 5, kc = ch & 31, t = n >> 4, h = n & 15, s = kc >> 1, hp0 = (kc & 1) * 8; float v[8];
#pragma unroll
        for (int e = 0; e < 8; ++e) v[e] = (s <= t) ? Kt[((t - s) * 16 + h) * 16 + hp0 + e] : 0.f;
        u32x4 o; o.x = cvt_pk_bf16(v[0], v[1]); o.y = cvt_pk_bf16(v[2], v[3]); o.z = cvt_pk_bf16(v[4], v[5]); o.w = cvt_pk_bf16(v[6], v[7]);
        *(u32x4*)(KinT + (size_t)n * 256 + kc * 8) = o; }
    for (int ch = tid; ch < 4096; ch += NTHR) { const int n = ch >> 5, kc = ch & 31, nb = n >> 5, j = n & 31, p = 32 * (nb >> 1) + j, part = nb & 1, s = kc >> 1, hp0 = (kc & 1) * 8; float v[8];
        const float2 l = lamp[(15 - s) * 64 + p];
#pragma unroll
        for (int e = 0; e < 8; ++e) { const float2 w = cmul(l, bbm[p * 16 + hp0 + e]); v[e] = part ? w.y : w.x; }
        u32x4 o; o.x = cvt_pk_bf16(v[0], v[1]); o.y = cvt_pk_bf16(v[2], v[3]); o.z = cvt_pk_bf16(v[4], v[5]); o.w = cvt_pk_bf16(v[6], v[7]);
        *(u32x4*)(WstT + (size_t)n * 256 + kc * 8) = o; }
    for (int ch = tid; ch < 4096; ch += NTHR) { const int n = ch >> 4, kc = ch & 15, t = n >> 4, h = n & 15; float v[8];
#pragma unroll
        for (int e = 0; e < 8; ++e) { const int k2 = kc * 8 + e, nb2 = k2 >> 5, j2 = k2 & 31, p = 32 * (nb2 >> 1) + j2, part = nb2 & 1;
            const float2 w = cmul(cm[h * 64 + p], lamp[(t + 1) * 64 + p]); v[e] = part ? -w.y : w.x; }
        u32x4 o; o.x = cvt_pk_bf16(v[0], v[1]); o.y = cvt_pk_bf16(v[2], v[3]); o.z = cvt_pk_bf16(v[4], v[5]); o.w = cvt_pk_bf16(v[6], v[7]);
        *(u32x4*)(WinT + (size_t)n * 128 + kc * 8) = o; }
    __syncthreads();
}

__device__ __forceinline__ void p0_prologue(const Args& A, char* lds, int G) {
    const int tid = threadIdx.x, lane = tid & 63, wave = tid >> 6;
    const int bx = blockIdx.x;
    for (int g = bx; g < NGRP; g += G) ssm_mats(A, g, lds);
    float* scr = (float*)(lds + wave * 16384);
    const int gw = bx * NWAVES + wave, NGW = G * NWAVES;
    bf16_t* Win_t = (bf16_t*)(A.ws + WS_WIN); bf16_t* Wglu_t = (bf16_t*)(A.ws + WS_WGLU); bf16_t* Wout_t = (bf16_t*)(A.ws + WS_WOUT);
    bf16_t* Wgu_t = (bf16_t*)(A.ws + WS_WGU); bf16_t* Wdn_t = (bf16_t*)(A.ws + WS_WDN);
    constexpr int I_IN = 16 * 64, I_GLU = 8 * 16, I_OUT = 16 * 32, I_G = 16 * 88, I_U = 16 * 88, I_D = 44 * 32;
    constexpr int NITEMS = I_IN + I_GLU + I_OUT + I_G + I_U + I_D;
    for (int it = gw; it < NITEMS; it += NGW) {
        int r = it;
        if (r < I_IN) { const int kb = r / 64, nb = r % 64, n0 = 32 * nb; const int drow0 = (n0 < 1024) ? n0 : (n0 < 1536 ? n0 + 512 : n0 - 512);
            transpose_item(A.w_in, 2048, Win_t, 1024, 64 * kb, n0, drow0, 64 * kb, nullptr, scr, lane); continue; } r -= I_IN;
        if (r < I_GLU) { const int kb = r / 16, nb = r % 16; transpose_item(A.w_glu, 512, Wglu_t, 512, 64 * kb, 32 * nb, 32 * nb, 64 * kb, nullptr, scr, lane); continue; } r -= I_GLU;
        if (r < I_OUT) { const int kb = r / 32, nb = r % 32, k0 = 64 * kb; const bool ssm = k0 >= 512;
            transpose_item(A.w_out, 1024, Wout_t, 1024, k0, 32 * nb, 32 * nb, ssm ? k0 - 512 : k0 + 512, ssm ? (A.ssm_norm_g - 512) : A.attn_norm_g, scr, lane); continue; } r -= I_OUT;
        if (r < I_G) { const int kb = r / 88, nb = r % 88, n0 = 32 * nb; transpose_item(A.w_gate, DFF, Wgu_t, 1024, 64 * kb, n0, 256 * (n0 / 128) + (n0 % 128), 64 * kb, A.norm2_g, scr, lane); continue; } r -= I_G;
        if (r < I_U) { const int kb = r / 88, nb = r % 88, n0 = 32 * nb; transpose_item(A.w_up, DFF, Wgu_t, 1024, 64 * kb, n0, 256 * (n0 / 128) + 128 + (n0 % 128), 64 * kb, A.norm2_g, scr, lane); continue; } r -= I_U;
        { const int kb = r / 32, nb = r % 32; transpose_item(A.w_down, 1024, Wdn_t, DFF, 64 * kb, 32 * nb, 32 * nb, 64 * kb, nullptr, scr, lane); }
    }
    bf16_t* XN = (bf16_t*)(A.ws + WS_XN);
    f32x4 gv[4];
#pragma unroll
    for (int j = 0; j < 4; ++j) gv[j] = ((const f32x4*)A.norm1_g)[lane + 64 * j];
    for (int m = gw; m < MTOK; m += NGW) {
        const f32x4* xr = (const f32x4*)(A.x + (size_t)m * DM) + lane; f32x4 v[4]; float s = 0.f;
#pragma unroll
        for (int j = 0; j < 4; ++j) { v[j] = xr[64 * j]; s += (v[j][0] * v[j][0] + v[j][1] * v[j][1]) + (v[j][2] * v[j][2] + v[j][3] * v[j][3]); }
        const float rs = 1.0f / sqrtf(wave_sum(s) * (1.0f / DM) + EPS);
        u32x2* o8 = (u32x2*)(XN + (size_t)m * DM) + lane;
#pragma unroll
        for (int j = 0; j < 4; ++j) { u32x2 w; w.x = cvt_pk_bf16(v[j][0] * rs * gv[j][0], v[j][1] * rs * gv[j][1]); w.y = cvt_pk_bf16(v[j][2] * rs * gv[j][2], v[j][3] * rs * gv[j][3]); o8[64 * j] = w; }
    }
}

__device__ __forceinline__ float gelu_tanh(float y) {
    const float u = 0.7978845608028654f * (y + 0.044715f * y * y * y);
    return y * __builtin_amdgcn_rcpf(1.0f + __builtin_amdgcn_exp2f(-2.0f * 1.4426950408889634f * u));
}
__device__ __forceinline__ void ssm_item(const Args& A, int b, int g, char* lds) {
    const int tid = threadIdx.x, lane = tid & 63, w = __builtin_amdgcn_readfirstlane(tid >> 6), j = lane & 31, hi = lane >> 5;
    float2* E = (float2*)lds;
    bf16_t* XS = (bf16_t*)(lds + 65536);
    float2* SEG = (float2*)(lds + 65536 + 69632);
    const bf16_t* PROJ = (const bf16_t*)(A.ws + WS_PROJ);
    const bf16_t* WstT = (const bf16_t*)(A.ws + WS_SSM + (size_t)g * 262144); const bf16_t* KinT = WstT + 128 * 256; const bf16_t* WinT = KinT + 256 * 256;
    const float2* LAM16 = (const float2*)(A.ws + WS_LAM16);
    bf16_t* YG = (bf16_t*)(A.ws + WS_YG);
    bf16x8 ua[16];
    { const bf16_t* up = PROJ + ((size_t)(b * SEQ + 16 * (32 * w + j))) * PROJ_LD + 1024 + g * 16 + 8 * hi;
#pragma unroll
      for (int tl = 0; tl < 16; ++tl) ua[tl] = *(const bf16x8*)(up + (size_t)tl * PROJ_LD); }
#pragma unroll 1
    for (int hp = 0; hp < 2; ++hp) {
        f32x16 are = {}, aim = {};
        const bf16_t* brp = WstT + (size_t)(64 * hp + j) * 256 + 8 * hi; const bf16_t* bip = brp + 32 * 256;
#pragma unroll
        for (int ks = 0; ks < 16; ++ks) { const bf16x8 br = *(const bf16x8*)(brp + 16 * ks), bi = *(const bf16x8*)(bip + 16 * ks);
            are = __builtin_amdgcn_mfma_f32_32x32x16_bf16(ua[ks], br, are, 0, 0, 0); aim = __builtin_amdgcn_mfma_f32_32x32x16_bf16(ua[ks], bi, aim, 0, 0, 0); }
#pragma unroll
        for (int r = 0; r < 16; ++r) E[(32 * w + crow(r, hi)) * 32 + j] = make_float2(are[r], aim[r]);
        __syncthreads();
        { const int seg = tid >> 5, pl = tid & 31; const float2 l16 = LAM16[g * 64 + 32 * hp + pl];
          float2 x = make_float2(0.f, 0.f);
          for (int i = 0; i < 16; ++i) { const float2 e = E[(16 * seg + i) * 32 + pl]; const float2 t = cmul(l16, x); x = make_float2(t.x + e.x, t.y + e.y); }
          SEG[seg * 32 + pl] = x;
          __syncthreads();
          float2 l256 = l16;
#pragma unroll
          for (int q = 0; q < 4; ++q) l256 = cmul(l256, l256);
          float2 xs = make_float2(0.f, 0.f);
          for (int s2 = 0; s2 < seg; ++s2) { const float2 e = SEG[s2 * 32 + pl]; const float2 t = cmul(l256, xs); xs = make_float2(t.x + e.x, t.y + e.y); }
          x = xs;
          for (int i = 0; i < 16; ++i) { const int c = 16 * seg + i; XS[c * 136 + 64 * hp + pl] = bf1(x.x); XS[c * 136 + 64 * hp + 32 + pl] = bf1(x.y);
              const float2 e = E[c * 32 + pl]; const float2 t = cmul(l16, x); x = make_float2(t.x + e.x, t.y + e.y); } }
        __syncthreads();
    }
#pragma unroll
    for (int nbh = 0; nbh < 2; ++nbh) {
        f32x16 acc[4]; acc[0] = f32x16{}; acc[1] = f32x16{}; acc[2] = f32x16{}; acc[3] = f32x16{};
        const bf16_t* kp = KinT + (size_t)(128 * nbh + j) * 256 + 8 * hi;
#pragma unroll
        for (int ks = 0; ks < 16; ++ks)
#pragma unroll
            for (int q = 0; q < 4; ++q) { if (ks <= 2 * (4 * nbh + q) + 1) {
                    const bf16x8 bv = *(const bf16x8*)(kp + (size_t)q * 32 * 256 + 16 * ks); acc[q] = __builtin_amdgcn_mfma_f32_32x32x16_bf16(ua[ks], bv, acc[q], 0, 0, 0); } }
        const bf16_t* wp = WinT + (size_t)(128 * nbh + j) * 128 + 8 * hi;
#pragma unroll
        for (int k2 = 0; k2 < 8; ++k2) { const bf16x8 av = *(const bf16x8*)(XS + (32 * w + j) * 136 + 16 * k2 + 8 * hi);
#pragma unroll
            for (int q = 0; q < 4; ++q) { const bf16x8 bv = *(const bf16x8*)(wp + (size_t)q * 32 * 128 + 16 * k2); acc[q] = __builtin_amdgcn_mfma_f32_32x32x16_bf16(av, bv, acc[q], 0, 0, 0); } }
#pragma unroll
        for (int q = 0; q < 4; ++q) { const int n = 128 * nbh + 32 * q + j, t = n >> 4, h = n & 15;
#pragma unroll
            for (int r = 0; r < 16; ++r) { const int c = 32 * w + crow(r, hi); const int tok = 16 * c + t;
                YG[(size_t)(b * SEQ + tok) * DSSM + g * 16 + h] = bf1(gelu_tanh(acc[q][r])); } }
    }
    __syncthreads();
}

constexpr float ATT_SC = 0.125f * 1.4426950408889634f;
constexpr float ATT_STOP = 160.0f;
__device__ __forceinline__ void attn_item(const Args& A, int b, int qt, char* lds) {
    const int tid = threadIdx.x, lane = tid & 63, h = __builtin_amdgcn_readfirstlane(tid >> 6), j = lane & 31, hi = lane >> 5;
    float* OST = (float*)lds + h * (32 * 68);
    float* PART = (float*)(lds + 69632);
    const bf16_t* PROJ = (const bf16_t*)(A.ws + WS_PROJ);
    const bf16_t* VT = (const bf16_t*)(A.ws + WS_VT);
    bf16_t* Z = (bf16_t*)(A.ws + WS_Z);
    const int q0 = 32 * qt; const size_t rowbase = (size_t)b * SEQ;
    bf16x8 qf[4];
    { const bf16_t* qp = PROJ + (rowbase + q0 + j) * PROJ_LD + h * 64 + 8 * hi;
#pragma unroll
      for (int d0 = 0; d0 < 4; ++d0) qf[d0] = *(const bf16x8*)(qp + 16 * d0); }
    const bf16_t* kbase = PROJ + rowbase * PROJ_LD + 512 + h * 64 + 8 * hi;
    const bf16_t* vbase = VT + (size_t)(h * 64 + j) * MTOK + rowbase + 4 * hi;
    f32x16 o0 = {}, o1 = {}; float R2 = 0.f;
    bf16x8 kf[4]; s16x4 va[2][2], vb[2][2];
#define LOADKV(kt_) do { const int k0_ = 32 * (kt_); const bf16_t* kp_ = kbase + (size_t)(k0_ + j) * PROJ_LD; \
        _Pragma("unroll") for (int d0 = 0; d0 < 4; ++d0) kf[d0] = *(const bf16x8*)(kp_ + 16 * d0); \
        _Pragma("unroll") for (int db = 0; db < 2; ++db) _Pragma("unroll") for (int ks = 0; ks < 2; ++ks) { const bf16_t* vp_ = vbase + (size_t)db * 32 * MTOK + k0_ + 16 * ks; \
            va[db][ks] = *(const s16x4*)(vp_); vb[db][ks] = *(const s16x4*)(vp_ + 8); } } while (0)
    LOADKV(qt);
    for (int kt = qt; kt >= 0; --kt) {
        f32x16 s = {};
#pragma unroll
        for (int d0 = 0; d0 < 4; ++d0) s = __builtin_amdgcn_mfma_f32_32x32x16_bf16(kf[d0], qf[d0], s, 0, 0, 0);
        bf16x8 vf[2][2];
#pragma unroll
        for (int db = 0; db < 2; ++db)
#pragma unroll
            for (int ks = 0; ks < 2; ++ks) vf[db][ks] = (bf16x8){va[db][ks][0], va[db][ks][1], va[db][ks][2], va[db][ks][3], vb[db][ks][0], vb[db][ks][1], vb[db][ks][2], vb[db][ks][3]};
        if (kt > 0) LOADKV(kt - 1);
        const bool diag = (kt == qt);
        float L[16], z2[16];
#pragma unroll
        for (int r = 0; r < 16; ++r) { const float z = s[r] * ATT_SC; const float e = __builtin_amdgcn_exp2f(-fabsf(z));
            const float l = fmaxf(z, 0.f) + __builtin_amdgcn_logf(1.0f + e);
            const bool msk = diag && (crow(r, hi) >= j); L[r] = msk ? 0.f : l; z2[r] = msk ? -1e30f : z; }
        float gs[4], pg[4];
#pragma unroll
        for (int g4 = 0; g4 < 4; ++g4) { gs[g4] = (L[4 * g4] + L[4 * g4 + 1]) + (L[4 * g4 + 2] + L[4 * g4 + 3]); pg[g4] = __shfl_xor(gs[g4], 32); }
        float T[4]; T[3] = 0.f; T[2] = gs[3] + pg[3]; T[1] = T[2] + (gs[2] + pg[2]); T[0] = T[1] + (gs[1] + pg[1]);
        const float total = T[0] + (gs[0] + pg[0]);
        float wv[16];
#pragma unroll
        for (int g4 = 0; g4 < 4; ++g4) { const float after = T[g4] + (hi == 0 ? pg[g4] : 0.f) + R2;
            const float s3 = after, s2 = s3 + L[4 * g4 + 3], s1 = s2 + L[4 * g4 + 2], s0 = s1 + L[4 * g4 + 1];
            wv[4 * g4 + 3] = __builtin_amdgcn_exp2f(z2[4 * g4 + 3] - L[4 * g4 + 3] - s3);
            wv[4 * g4 + 2] = __builtin_amdgcn_exp2f(z2[4 * g4 + 2] - L[4 * g4 + 2] - s2);
            wv[4 * g4 + 1] = __builtin_amdgcn_exp2f(z2[4 * g4 + 1] - L[4 * g4 + 1] - s1);
            wv[4 * g4 + 0] = __builtin_amdgcn_exp2f(z2[4 * g4 + 0] - L[4 * g4 + 0] - s0); }
        R2 += total;
        u32x4 p0, p1;
        p0.x = cvt_pk_bf16(wv[0], wv[1]); p0.y = cvt_pk_bf16(wv[2], wv[3]); p0.z = cvt_pk_bf16(wv[4], wv[5]); p0.w = cvt_pk_bf16(wv[6], wv[7]);
        p1.x = cvt_pk_bf16(wv[8], wv[9]); p1.y = cvt_pk_bf16(wv[10], wv[11]); p1.z = cvt_pk_bf16(wv[12], wv[13]); p1.w = cvt_pk_bf16(wv[14], wv[15]);
        const bf16x8 pa0 = __builtin_bit_cast(bf16x8, p0), pa1 = __builtin_bit_cast(bf16x8, p1);
        o0 = __builtin_amdgcn_mfma_f32_32x32x16_bf16(pa0, vf[0][0], o0, 0, 0, 0); o0 = __builtin_amdgcn_mfma_f32_32x32x16_bf16(pa1, vf[0][1], o0, 0, 0, 0);
        o1 = __builtin_amdgcn_mfma_f32_32x32x16_bf16(pa0, vf[1][0], o1, 0, 0, 0); o1 = __builtin_amdgcn_mfma_f32_32x32x16_bf16(pa1, vf[1][1], o1, 0, 0, 0);
        if (__all(R2 > ATT_STOP)) break;
    }
#undef LOADKV
#pragma unroll
    for (int r = 0; r < 16; ++r) { OST[crow(r, hi) * 68 + j] = o0[r]; OST[crow(r, hi) * 68 + 32 + j] = o1[r]; }
    asm volatile("s_waitcnt lgkmcnt(0)" ::: "memory");
    f32x4 ov[8]; float ss = 0.f;
#pragma unroll
    for (int e = 0; e < 8; ++e) { ov[e] = *(const f32x4*)(OST + j * 68 + 32 * hi + 4 * e); ss += (ov[e][0] * ov[e][0] + ov[e][1] * ov[e][1]) + (ov[e][2] * ov[e][2] + ov[e][3] * ov[e][3]); }
    PART[(h * 32 + j) * 2 + hi] = ss;
    __syncthreads();
    float tot = 0.f;
#pragma unroll
    for (int w2 = 0; w2 < 8; ++w2) { tot += PART[(w2 * 32 + j) * 2] + PART[(w2 * 32 + j) * 2 + 1]; }
    const float rs = 1.0f / sqrtf(tot * (1.0f / DATT) + EPS);
    bf16_t* zp = Z + (rowbase + q0 + j) * 1024 + 512 + h * 64 + 32 * hi;
#pragma unroll
    for (int e = 0; e < 4; ++e) { const f32x4 a = ov[2 * e] * rs, c = ov[2 * e + 1] * rs; u32x4 w;
        w.x = cvt_pk_bf16(a[0], a[1]); w.y = cvt_pk_bf16(a[2], a[3]); w.z = cvt_pk_bf16(c[0], c[1]); w.w = cvt_pk_bf16(c[2], c[3]); *(u32x4*)(zp + 8 * e) = w; }
    __syncthreads();
}


#define LAS __attribute__((address_space(3)))
#define XB_TMO      128
#define XB_XCNT(j)  (256  + 64 * (j))
#define XB_XSUB(j)  (1280 + 64 * (j))
#define XB_XGEN(j)  (2304 + 64 * (j))
#define XB_TOP      3328
#define XB_TOPGEN   3392
#define XCD_BAR_WORDS 3456
#define XB_SPIN_CAP (1u << 18)
__device__ __forceinline__ unsigned xb_ld(unsigned* p)              { return __hip_atomic_load(p, __ATOMIC_RELAXED, __HIP_MEMORY_SCOPE_AGENT); }
__device__ __forceinline__ unsigned xb_add(unsigned* p, unsigned v) { return __hip_atomic_fetch_add(p, v, __ATOMIC_RELAXED, __HIP_MEMORY_SCOPE_AGENT); }
__device__ __forceinline__ unsigned xb_xcc_id() { return (unsigned)__builtin_amdgcn_s_getreg((3 << 11) | 20) & 0xFu; }
#define XB_SPIN(cond, bar) do { unsigned _sp = 0; while (cond) { __builtin_amdgcn_s_sleep(1); \
    if ((++_sp & 255u) == 0u) { if (xb_ld(&(bar)[XB_TMO])) break; if (_sp > XB_SPIN_CAP) { atomicAdd(&(bar)[XB_TMO], 1u); break; } } } } while (0)
struct XcdBarrier { unsigned* bar; unsigned x; volatile LAS unsigned* st; };
__device__ __forceinline__ XcdBarrier xcd_barrier_post(unsigned* bar, volatile LAS unsigned* st) {
    XcdBarrier b; b.bar = bar; b.x = xb_xcc_id(); b.st = st;
    if (threadIdx.x == 0) (void)xb_add(&bar[XB_XCNT(b.x)], 1u);
    return b;
}
__device__ __forceinline__ void xcd_barrier_complete(unsigned* bar, unsigned x, unsigned& nloc, unsigned& nx) {
    const unsigned G = gridDim.x * gridDim.y * gridDim.z;
    unsigned sum, cnt, mine, sp = 0u;
    for (;;) {
        sum = 0u; cnt = 0u; mine = 0u;
#pragma unroll
        for (unsigned j = 0; j < 16; ++j) { const unsigned c = xb_ld(&bar[XB_XCNT(j)]); sum += c; cnt += (c > 0u) ? 1u : 0u; mine = (j == x) ? c : mine; }
        if (sum == G) break;
        __builtin_amdgcn_s_sleep(1);
        if ((++sp & 255u) == 0u) { if (xb_ld(&bar[XB_TMO])) break; if (sp > XB_SPIN_CAP) { atomicAdd(&bar[XB_TMO], 1u); break; } }
    }
    nloc = mine > 0u ? mine : 1u; nx = cnt > 0u ? cnt : 1u;
}
__device__ __forceinline__ void xcd_barrier(const XcdBarrier& b) {
    asm volatile("s_waitcnt vmcnt(0)" ::: "memory");
    __syncthreads();
    if (threadIdx.x == 0) {
        unsigned* bar = b.bar;
        __builtin_amdgcn_s_waitcnt(0);
        unsigned nloc = b.st[0], nx = b.st[1];
        if (nloc == 0u) { xcd_barrier_complete(bar, b.x, nloc, nx); b.st[0] = nloc; b.st[1] = nx; }
        const unsigned old = xb_add(&bar[XB_XSUB(b.x)], 1u);
        const unsigned gen = old / nloc;
        if (old + 1u == (gen + 1u) * nloc) {
            __builtin_amdgcn_fence(__ATOMIC_RELEASE, "agent");
            asm volatile("s_waitcnt vmcnt(0)" ::: "memory");
            const unsigned og = xb_add(&bar[XB_TOP], 1u);
            const unsigned tg = og / nx;
            if (og + 1u == (tg + 1u) * nx) xb_add(&bar[XB_TOPGEN], 1u);
            else XB_SPIN(xb_ld(&bar[XB_TOPGEN]) == tg, bar);
            __builtin_amdgcn_fence(__ATOMIC_ACQUIRE, "agent");
            xb_add(&bar[XB_XGEN(b.x)], 1u);
            asm volatile("s_waitcnt vmcnt(0)" ::: "memory");
        } else {
            XB_SPIN(xb_ld(&bar[XB_XGEN(b.x)]) == gen, bar);
            __builtin_amdgcn_fence(__ATOMIC_ACQUIRE, "agent");
            asm volatile("s_waitcnt vmcnt(0)" ::: "memory");
        }
    }
    __syncthreads();
}

__global__ void __launch_bounds__(NTHR, 2) hymba_fwd(Args A) {
    extern __shared__ __attribute__((aligned(16))) unsigned char lds[];
    cg::grid_group grid = cg::this_grid();
    const int G = gridDim.x, bx = blockIdx.x;
    PG8_LAS unsigned char* lds3 = (PG8_LAS unsigned char*)lds;
    volatile LAS unsigned* MISC = (volatile LAS unsigned*)(lds3 + MISC_OFF);
    if (threadIdx.x < 32) MISC[threadIdx.x] = 0u;
    __syncthreads();
    XcdBarrier bar = xcd_barrier_post((unsigned*)(A.ws + WS_CTL) + CW_BAR, MISC + 8);
#ifdef PROBE_K
    volatile LAS unsigned long long* STAMP = (volatile LAS unsigned long long*)(lds3 + MISC_OFF + 128);
#define STAMPIT(i) do { if (threadIdx.x == 0) STAMP[i] = __builtin_amdgcn_s_memrealtime(); } while (0)
#else
#define STAMPIT(i) do {} while (0)
#endif
    STAMPIT(0);

#ifndef NO_P0
    p0_prologue(A, (char*)lds, G);
#endif
    grid.sync();
    STAMPIT(1);

#ifndef NO_P1
    {
        pg8::Gemm g{(const bf16_t*)(A.ws + WS_XN), (const bf16_t*)(A.ws + WS_WIN), MTOK, 1536, DM}; pg8::StaticOrder S; S.init(MTOK, 1536, G, bx);
        pg8::EpiStore E{(bf16_t*)(A.ws + WS_PROJ), PROJ_LD};
        pg8::gemm_phase<pg8::EpiStore, pg8::StaticOrder, true, true, false>(lds3, g, S, E, nullptr, 0.f);
        pg8::Gemm g2{(const bf16_t*)(A.ws + WS_WIN) + (size_t)1536 * DM, (const bf16_t*)(A.ws + WS_XN), 512, MTOK, DM}; pg8::StaticOrder S2; S2.init(512, MTOK, G, bx);
        pg8::EpiStore E2{(bf16_t*)(A.ws + WS_VT), MTOK};
        pg8::gemm_phase<pg8::EpiStore, pg8::StaticOrder, true, true, false>(lds3, g2, S2, E2, nullptr, 0.f);
    }
#endif
    xcd_barrier(bar);
    STAMPIT(2);

#ifndef NO_SSM
    for (int it = bx; it < NB * NGRP; it += G) ssm_item(A, it >> 5, it & 31, (char*)lds);
#endif
#ifndef NO_ATT
    for (int it = bx; it < NB * (SEQ / 32); it += G) attn_item(A, it >> 7, it & 127, (char*)lds);
#endif
    xcd_barrier(bar);
    STAMPIT(3);

#ifndef NO_P3
    {
        pg8::Gemm g{(const bf16_t*)(A.ws + WS_YG), (const bf16_t*)(A.ws + WS_WGLU), MTOK, 512, 512}; pg8::StaticOrder S; S.init(MTOK, 512, G, bx);
        pg8::EpiGlu E{(const bf16_t*)(A.ws + WS_YG), (bf16_t*)(A.ws + WS_Z), (float*)(A.ws + WS_PART1)};
        pg8::gemm_phase<pg8::EpiGlu, pg8::StaticOrder, true, true, false>(lds3, g, S, E, nullptr, 0.f);
    }
#endif
    xcd_barrier(bar);
    STAMPIT(4);

#ifndef NO_P4
    {
        pg8::Gemm g{(const bf16_t*)(A.ws + WS_Z), (const bf16_t*)(A.ws + WS_WOUT), MTOK, DM, DM}; pg8::StaticOrder S; S.init(MTOK, DM, G, bx);
        pg8::EpiRes E{A.x, A.out, (bf16_t*)(A.ws + WS_XN), (float*)(A.ws + WS_PART2)};
        pg8::gemm_phase<pg8::EpiRes, pg8::StaticOrder, true, true, true>(lds3, g, S, E, (const float*)(A.ws + WS_PART1), EPS);
    }
#endif
    xcd_barrier(bar);
    STAMPIT(5);

#ifndef NO_P5
    {
        pg8::Gemm g{(const bf16_t*)(A.ws + WS_XN), (const bf16_t*)(A.ws + WS_WGU), MTOK, 2 * DFF, DM}; pg8::StaticOrder S; S.init(MTOK, 2 * DFF, G, bx);
        pg8::EpiGateUp E{(bf16_t*)(A.ws + WS_H), (const float*)(A.ws + WS_PART2), EPS};
        pg8::gemm_phase<pg8::EpiGateUp, pg8::StaticOrder, true, true, false>(lds3, g, S, E, nullptr, 0.f);
    }
#endif
    xcd_barrier(bar);
    STAMPIT(6);

#ifndef NO_P6
    {
        pg8::Gemm g{(const bf16_t*)(A.ws + WS_H), (const bf16_t*)(A.ws + WS_WDN), MTOK, DM, DFF}; pg8::StaticOrder S; S.init(MTOK, DM, G, bx);
        pg8::EpiRes E{A.out, A.out, nullptr, (float*)(A.ws + WS_PART3)};
        pg8::gemm_phase<pg8::EpiRes, pg8::StaticOrder, true, true, false>(lds3, g, S, E, nullptr, 0.f);
    }
#endif
    xcd_barrier(bar);
    STAMPIT(7);

    {
        int tid7 = threadIdx.x; asm volatile("" : "+v"(tid7));
        const int wave = tid7 >> 6, lane = tid7 & 63;
        const int gw = bx * NWAVES + wave, NGW = G * NWAVES;
        f32x4 gv[4];
#pragma unroll
        for (int j = 0; j < 4; ++j) gv[j] = ((const f32x4*)A.final_norm_g)[lane + 64 * j];
        const float* part = (const float*)(A.ws + WS_PART3);
        for (int m = gw; m < MTOK; m += NGW) {
            const f32x4* pp = (const f32x4*)(part + (size_t)m * 16); const f32x4 p0 = pp[0], p1 = pp[1], p2 = pp[2], p3 = pp[3];
            const float s = ((p0[0] + p0[1]) + (p0[2] + p0[3])) + ((p1[0] + p1[1]) + (p1[2] + p1[3])) + ((p2[0] + p2[1]) + (p2[2] + p2[3])) + ((p3[0] + p3[1]) + (p3[2] + p3[3]));
            const float rs = 1.0f / sqrtf(s * (1.0f / DM) + EPS);
            f32x4* xr = (f32x4*)(A.out + (size_t)m * DM) + lane;
#pragma unroll
            for (int j = 0; j < 4; ++j) { const f32x4 v = xr[64 * j]; xr[64 * j] = v * rs * gv[j]; }
        }
    }
#ifdef PROBE_K
    STAMPIT(8);
    if (bx == 0 && threadIdx.x == 0) { const unsigned long long dt = STAMP[PROBE_K + 1] - STAMP[PROBE_K]; const unsigned long long t0 = __builtin_amdgcn_s_memrealtime(); while (__builtin_amdgcn_s_memrealtime() - t0 < dt) __builtin_amdgcn_s_sleep(8); }
#endif
}

extern "C" void kernel_launch(void* const* d_in, const int* in_sizes, int n_in, void* d_out, int out_size, void* d_ws, size_t ws_size, hipStream_t stream) {
    static int grid = 0;
    if (grid == 0) {
        if (n_in != 20 || in_sizes[0] != MTOK * DM || out_size != MTOK * DM || ws_size < WS_END) { fprintf(stderr, "kernel_launch: unexpected problem shape / workspace (%d inputs, ws %zu)\n", n_in, ws_size); grid = -1; return; }
        int dev = 0, cus = 0, per_cu = 0;
        if (hipGetDevice(&dev) != hipSuccess || hipDeviceGetAttribute(&cus, hipDeviceAttributeMultiprocessorCount, dev) != hipSuccess) { grid = -1; return; }
        if (hipFuncSetAttribute((const void*)hymba_fwd, hipFuncAttributeMaxDynamicSharedMemorySize, LDS_BYTES) != hipSuccess) { fprintf(stderr, "kernel_launch: hipFuncSetAttribute failed\n"); grid = -1; return; }
        if (hipOccupancyMaxActiveBlocksPerMultiprocessor(&per_cu, (const void*)hymba_fwd, NTHR, LDS_BYTES) != hipSuccess || per_cu < 1) { fprintf(stderr, "kernel_launch: occupancy query says %d\n", per_cu); per_cu = 1; }
        (void)hipGetLastError();
        grid = cus * 1;
    }
    if (grid < 0) return;
    if (hipMemsetAsync((char*)d_ws + WS_CTL, 0, CTL_ZERO_BYTES, stream) != hipSuccess) { fprintf(stderr, "kernel_launch: memset failed\n"); return; }
    Args a{};
    const float** f = (const float**)&a;
    for (int i = 0; i < 20; ++i) f[i] = (const float*)d_in[i];
    a.out = (float*)d_out; a.ws = (unsigned char*)d_ws;
    void* args[] = {&a};
    hipError_t e = hipLaunchCooperativeKernel((const void*)hymba_fwd, dim3(grid), dim3(NTHR), args, LDS_BYTES, stream);
    if (e != hipSuccess) fprintf(stderr, "cooperative launch failed: %s (grid %d)\n", hipGetErrorString(e), grid);
}
```

```cpp
#include <hip/hip_runtime.h>
#include <hip/hip_cooperative_groups.h>
#include <cstdio>
#include <cstdint>
namespace cg = cooperative_groups;

namespace pg8 {
#define PG8_LAS __attribute__((address_space(3)))
typedef unsigned short bf16_t;
typedef short bf16x8 __attribute__((ext_vector_type(8)));
typedef float f32x4 __attribute__((ext_vector_type(4)));
typedef float f32x2 __attribute__((ext_vector_type(2)));
typedef unsigned u32x4 __attribute__((ext_vector_type(4)));
typedef unsigned u32x2 __attribute__((ext_vector_type(2)));
constexpr int BM = 256, BK = 64, HALF = 128, HTB = HALF * BK * 2, STAGE_BYTES = 8 * HTB, NXCD = 8, WGM = 8;

__host__ __device__ __forceinline__ int lds_byte(int r, int c) { const int st = (r >> 4) * 2 + (c >> 5), rr = r & 15, cc = c & 31, ob = rr * 64 + cc * 2; return st * 1024 + (ob ^ (((ob >> 9) & 1) << 5)); }
__host__ __device__ __forceinline__ void stage_rc(int b, int& R, int& C) { const int st = b / 1024, sb = b % 1024, swz = sb ^ (((sb >> 9) & 1) << 5); R = (st >> 1) * 16 + swz / 64; C = (st & 1) * 32 + (swz % 64) / 2; }
__host__ __device__ __forceinline__ int perm32(int rho) { const int n = rho >> 4, i = rho & 15; return 8 * (i >> 2) + 4 * n + (i & 3); }

struct Unit { int pm, pn; };
struct Gemm { const bf16_t* A; const bf16_t* Bt; int M, N, K; };

struct StaticOrder {
    int nM, nN, nwg, G, c;
    __host__ __device__ void init(int M, int N, int G_, int c_) { nM = M / BM; nN = N / BM; nwg = nM * nN; G = G_; c = c_; }
    __host__ __device__ bool next(int i, Unit& u) const {
        const long L = (long)i * G + c; if (L >= nwg) return false;
        int wgid = (int)L; { const int q = nwg / NXCD, r = nwg % NXCD, xcd = wgid % NXCD, off = wgid / NXCD; wgid = (xcd < r ? xcd * (q + 1) : r * (q + 1) + (xcd - r) * q) + off; }
        const int nig = WGM * nN, gid = wgid / nig, fm = gid * WGM, gsz = (nM - fm) < WGM ? (nM - fm) : WGM;
        u.pm = fm + ((wgid % nig) % gsz); u.pn = (wgid % nig) / gsz; return true;
    }
    __device__ __forceinline__ void a_ready(const Unit&) const {}
    __device__ __forceinline__ void done(const Unit&) const {}
};

__device__ __forceinline__ unsigned cvt_pk_bf16(float lo, float hi) { unsigned r; asm volatile("v_cvt_pk_bf16_f32 %0, %1, %2" : "=v"(r) : "v"(lo), "v"(hi)); return r; }
__device__ __forceinline__ float bf_lo(unsigned w) { return __uint_as_float(w << 16); }
__device__ __forceinline__ float bf_hi(unsigned w) { return __uint_as_float(w & 0xffff0000u); }

struct EpiStore {
    static constexpr bool PERM = true;
    bf16_t* O; int ldc;
    __device__ __forceinline__ void operator()(const f32x4 (&acc)[2][2][4][2], const Unit& u, int wr, int wc, int fr, int fq) const {
        asm volatile("" : "+v"(fr), "+v"(fq));
        const int row0 = u.pm * BM + wr * 64 + fr, col0 = u.pn * BM + wc * 32 + 8 * fq;
#pragma unroll
        for (int ai = 0; ai < 2; ++ai)
#pragma unroll
            for (int m = 0; m < 4; ++m) { bf16_t* rowp = O + (size_t)(row0 + ai * HALF + m * 16) * ldc + col0;
#pragma unroll
                for (int bj = 0; bj < 2; ++bj) { const f32x4 v0 = acc[ai][bj][m][0], v1 = acc[ai][bj][m][1];
                    u32x4 w; w.x = cvt_pk_bf16(v0[0], v0[1]); w.y = cvt_pk_bf16(v0[2], v0[3]); w.z = cvt_pk_bf16(v1[0], v1[1]); w.w = cvt_pk_bf16(v1[2], v1[3]);
                    *(u32x4*)(rowp + bj * HALF) = w; } }
    }
};
__device__ __forceinline__ float sigmoidf_fast(float a) { return __builtin_amdgcn_rcpf(1.0f + __builtin_amdgcn_exp2f(-1.4426950408889634f * a)); }
struct EpiGlu {
    static constexpr bool PERM = true;
    const bf16_t* Y; bf16_t* Z; float* part;
    __device__ __forceinline__ void operator()(const f32x4 (&acc)[2][2][4][2], const Unit& u, int wr, int wc, int fr, int fq) const {
        asm volatile("" : "+v"(fr), "+v"(fq));
        const int row0 = u.pm * BM + wr * 64 + fr, col0 = u.pn * BM + wc * 32 + 8 * fq;
#pragma unroll
        for (int ai = 0; ai < 2; ++ai)
#pragma unroll
            for (int m = 0; m < 4; ++m) { const int row = row0 + ai * HALF + m * 16; float ss = 0.f;
#pragma unroll
                for (int bj = 0; bj < 2; ++bj) { const int col = col0 + bj * HALF;
                    const u32x4 yv = *(const u32x4*)(Y + (size_t)row * 512 + col);
                    const f32x4 a0 = acc[ai][bj][m][0], a1 = acc[ai][bj][m][1];
                    float v[8];
                    v[0] = bf_lo(yv.x) * sigmoidf_fast(a0[0]); v[1] = bf_hi(yv.x) * sigmoidf_fast(a0[1]);
                    v[2] = bf_lo(yv.y) * sigmoidf_fast(a0[2]); v[3] = bf_hi(yv.y) * sigmoidf_fast(a0[3]);
                    v[4] = bf_lo(yv.z) * sigmoidf_fast(a1[0]); v[5] = bf_hi(yv.z) * sigmoidf_fast(a1[1]);
                    v[6] = bf_lo(yv.w) * sigmoidf_fast(a1[2]); v[7] = bf_hi(yv.w) * sigmoidf_fast(a1[3]);
#pragma unroll
                    for (int e = 0; e < 8; ++e) ss += v[e] * v[e];
                    u32x4 w; w.x = cvt_pk_bf16(v[0], v[1]); w.y = cvt_pk_bf16(v[2], v[3]); w.z = cvt_pk_bf16(v[4], v[5]); w.w = cvt_pk_bf16(v[6], v[7]);
                    *(u32x4*)(Z + (size_t)row * 1024 + col) = w; }
                ss += __shfl_xor(ss, 16); ss += __shfl_xor(ss, 32);
                if (fq == 0) part[(size_t)row * 8 + u.pn * 4 + wc] = ss; asm volatile("" ::: "memory"); }
    }
};
struct EpiRes {
    static constexpr bool PERM = false;
    const float* base; float* out; bf16_t* xb; float* part;
    __device__ __forceinline__ void operator()(const f32x4 (&acc)[2][2][4][2], const Unit& u, int wr, int wc, int fr, int fq) const {
        asm volatile("" : "+v"(fr), "+v"(fq));
        const int row0 = u.pm * BM + wr * 64 + fr, col0 = u.pn * BM + wc * 32 + 4 * fq;
#pragma unroll
        for (int ai = 0; ai < 2; ++ai)
#pragma unroll
            for (int m = 0; m < 4; ++m) { const int row = row0 + ai * HALF + m * 16; float ss = 0.f; const size_t off = (size_t)row * 1024 + col0;
#pragma unroll
                for (int bj = 0; bj < 2; ++bj)
#pragma unroll
                    for (int n = 0; n < 2; ++n) { const size_t o2 = off + bj * HALF + n * 16;
                        const f32x4 b = *(const f32x4*)(base + o2); const f32x4 v = b + acc[ai][bj][m][n];
                        *(f32x4*)(out + o2) = v; ss += (v[0] * v[0] + v[1] * v[1]) + (v[2] * v[2] + v[3] * v[3]);
                        if (xb) { u32x2 w; w.x = cvt_pk_bf16(v[0], v[1]); w.y = cvt_pk_bf16(v[2], v[3]); *(u32x2*)(xb + o2) = w; } }
                ss += __shfl_xor(ss, 16); ss += __shfl_xor(ss, 32);
                if (fq == 0) part[(size_t)row * 16 + u.pn * 4 + wc] = ss; asm volatile("" ::: "memory"); }
    }
};
struct EpiGateUp {
    static constexpr bool PERM = true;
    bf16_t* H; const float* part; float eps;
    __device__ __forceinline__ void operator()(const f32x4 (&acc)[2][2][4][2], const Unit& u, int wr, int wc, int fr, int fq) const {
        asm volatile("" : "+v"(fr), "+v"(fq));
        const int row0 = u.pm * BM + wr * 64 + fr, col0 = u.pn * HALF + wc * 32 + 8 * fq;
#pragma unroll
        for (int ai = 0; ai < 2; ++ai)
#pragma unroll
            for (int m = 0; m < 4; ++m) { const int row = row0 + ai * HALF + m * 16;
                const f32x4* pp = (const f32x4*)(part + (size_t)row * 16); const f32x4 p0 = pp[0], p1 = pp[1], p2 = pp[2], p3 = pp[3];
                const float s = ((p0[0] + p0[1]) + (p0[2] + p0[3])) + ((p1[0] + p1[1]) + (p1[2] + p1[3])) + ((p2[0] + p2[1]) + (p2[2] + p2[3])) + ((p3[0] + p3[1]) + (p3[2] + p3[3]));
                const float rs = 1.0f / sqrtf(s * (1.0f / 1024.0f) + eps);
                float v[8];
#pragma unroll
                for (int n = 0; n < 2; ++n)
#pragma unroll
                    for (int e = 0; e < 4; ++e) { const float g = acc[ai][0][m][n][e] * rs, up = acc[ai][1][m][n][e] * rs; v[n * 4 + e] = g * sigmoidf_fast(g) * up; }
                u32x4 w; w.x = cvt_pk_bf16(v[0], v[1]); w.y = cvt_pk_bf16(v[2], v[3]); w.z = cvt_pk_bf16(v[4], v[5]); w.w = cvt_pk_bf16(v[6], v[7]);
                *(u32x4*)(H + (size_t)row * 2816 + col0) = w; if (m & 1) asm volatile("" ::: "memory"); }
    }
};

template <class Epi, class Sched, bool ALIGN_EPI, bool SP2, bool MID>
__device__ __forceinline__ void gemm_phase(PG8_LAS unsigned char* lds, const Gemm g, const Sched& S, const Epi& E, const float* midp, float mid_eps) {
    int tid = threadIdx.x; asm volatile("" : "+v"(tid));
    const int wid = __builtin_amdgcn_readfirstlane(tid >> 6), lane = tid & 63, wr = wid >> 2, wc = wid & 3, fr = lane & 15, fq = lane >> 4;
    const int K = g.K, nt = K / BK;
    unsigned voffA[2], voffB[2];
#pragma unroll
    for (int i = 0; i < 2; ++i) { int R, C; stage_rc(tid * 16 + i * 8192, R, C); const int Rb = Epi::PERM ? ((R & ~31) + perm32(R & 31)) : R;
        voffA[i] = (unsigned)(R * K + C) * 2u; voffB[i] = (unsigned)(Rb * K + C) * 2u; }
    const size_t kstep = (size_t)(BK * 2);
    const size_t hstep = (size_t)HALF * K * 2;
    const size_t tstep = 2 * hstep;
    const unsigned ldsw = (unsigned)wid * 1024u;
    const int aoff = lds_byte(wr * 64 + fr, fq * 8), boff = lds_byte(wc * 32 + fr, fq * 8);
#define PG8_SA(b, h) (((b) * 2 + (h)) * HTB)
#define PG8_SB(b, h) ((4 + (b) * 2 + (h)) * HTB)
#define PG8_STAGE(bufoff, gbase, voff) do { _Pragma("unroll") for (int _i = 0; _i < 2; ++_i) \
        __builtin_amdgcn_global_load_lds((const unsigned*)((const char*)(gbase) + (voff)[_i]), (PG8_LAS unsigned*)(lds + (bufoff) + ldsw + _i * 8192), 16, 0, 0); } while (0)
#define PG8_LDA(dst, b, h) do { _Pragma("unroll") for (int m = 0; m < 4; ++m) _Pragma("unroll") for (int k = 0; k < 2; ++k) dst[m][k] = *(const PG8_LAS bf16x8*)(lds + PG8_SA(b, h) + aoff + m * 2048 + k * 1024); } while (0)
#define PG8_LDB(dst, b, h) do { _Pragma("unroll") for (int n = 0; n < 2; ++n) _Pragma("unroll") for (int k = 0; k < 2; ++k) dst[n][k] = *(const PG8_LAS bf16x8*)(lds + PG8_SB(b, h) + boff + n * 2048 + k * 1024); } while (0)
#define PG8_MMA(ai, bj, At, Bt) do { __builtin_amdgcn_s_setprio(1); _Pragma("unroll") for (int m = 0; m < 4; ++m) _Pragma("unroll") for (int n = 0; n < 2; ++n) _Pragma("unroll") for (int k = 0; k < 2; ++k) \
        acc[ai][bj][m][n] = __builtin_amdgcn_mfma_f32_16x16x32_bf16(Bt[n][k], At[m][k], acc[ai][bj][m][n], 0, 0, 0); __builtin_amdgcn_s_setprio(0); } while (0)
#define PG8_WAIT_V(n) asm volatile("s_waitcnt vmcnt(" #n ")" ::: "memory")
#define PG8_WAIT_L(n) asm volatile("s_waitcnt lgkmcnt(" #n ")" ::: "memory")
#define PG8_BAR __builtin_amdgcn_s_barrier()
#define PG8_SCHED __builtin_amdgcn_sched_barrier(0)
    Unit cur, nxt; int ui = 0;
    if (!S.next(0, cur)) return;
    f32x4 acc[2][2][4][2];
#pragma unroll
    for (int a = 0; a < 2; ++a)
#pragma unroll
        for (int b = 0; b < 2; ++b)
#pragma unroll
            for (int m = 0; m < 4; ++m)
#pragma unroll
                for (int n = 0; n < 2; ++n) acc[a][b][m][n] = (f32x4){0.f, 0.f, 0.f, 0.f};
    bf16x8 At[4][2], B0[2][2], B1[2][2];
    const char* cA = (const char*)g.A + (size_t)cur.pm * tstep; const char* cB = (const char*)g.Bt + (size_t)cur.pn * tstep;
    if constexpr (SP2) {
        PG8_STAGE(PG8_SB(0, 0), cB, voffB); PG8_STAGE(PG8_SB(0, 1), cB + hstep, voffB); PG8_STAGE(PG8_SA(0, 0), cA, voffA); PG8_STAGE(PG8_SA(0, 1), cA + hstep, voffA);
        if (wr == 1) PG8_BAR;
        PG8_WAIT_V(2); PG8_BAR;
        PG8_STAGE(PG8_SB(1, 0), cB + kstep, voffB); PG8_STAGE(PG8_SA(1, 0), cA + kstep, voffA); PG8_STAGE(PG8_SB(1, 1), cB + hstep + kstep, voffB);
        PG8_WAIT_V(6); PG8_BAR;
    } else {
        PG8_STAGE(PG8_SB(0, 0), cB, voffB); PG8_STAGE(PG8_SA(0, 0), cA, voffA); PG8_STAGE(PG8_SB(0, 1), cB + hstep, voffB); PG8_STAGE(PG8_SA(0, 1), cA + hstep, voffA);
        if (wr == 1) PG8_BAR;
        PG8_WAIT_V(4); PG8_BAR;
        PG8_STAGE(PG8_SB(1, 0), cB + kstep, voffB); PG8_STAGE(PG8_SA(1, 0), cA + kstep, voffA); PG8_STAGE(PG8_SB(1, 1), cB + hstep + kstep, voffB);
        PG8_WAIT_V(6); PG8_BAR;
    }
    for (;;) {
        const bool has_next = S.next(ui + 1, nxt);
        const char* nA = has_next ? (const char*)g.A + (size_t)nxt.pm * tstep : cA; const char* nB = has_next ? (const char*)g.Bt + (size_t)nxt.pn * tstep : cB;
        for (int t = 0; t < nt; t += 2) {
            const bool last = (t == nt - 2);
            const char* a1 = cA + (size_t)(t + 1) * kstep;
            const char* a2 = last ? nA : cA + (size_t)(t + 2) * kstep; const char* b2 = last ? nB : cB + (size_t)(t + 2) * kstep;
            const char* a3 = a2 + kstep; const char* b3 = b2 + kstep;
            if constexpr (MID) {
                if (t == (nt >> 1)) {
                    PG8_SCHED;
#pragma unroll
                    for (int ai = 0; ai < 2; ++ai)
#pragma unroll
                        for (int m = 0; m < 4; ++m) { const int row = cur.pm * BM + ai * HALF + wr * 64 + m * 16 + fr;
                            const f32x4 p0 = *(const f32x4*)(midp + (size_t)row * 8), p1 = *(const f32x4*)(midp + (size_t)row * 8 + 4);
                            const float s = ((p0[0] + p0[1]) + (p0[2] + p0[3])) + ((p1[0] + p1[1]) + (p1[2] + p1[3]));
                            const float rs = 1.0f / sqrtf(s * (1.0f / 512.0f) + mid_eps);
#pragma unroll
                            for (int bj = 0; bj < 2; ++bj)
#pragma unroll
                                for (int n = 0; n < 2; ++n) acc[ai][bj][m][n] = acc[ai][bj][m][n] * rs; asm volatile("" ::: "memory"); }
                    PG8_WAIT_V(0);
                    PG8_SCHED;
                }
            }
            if constexpr (SP2) {
            PG8_LDB(B0, 0, 0); PG8_LDB(B1, 0, 1); PG8_SCHED; PG8_LDA(At, 0, 0); PG8_STAGE(PG8_SA(1, 1), a1 + hstep, voffA);
            PG8_WAIT_V(8); PG8_WAIT_L(0); PG8_BAR; PG8_MMA(0, 0, At, B0); PG8_MMA(0, 1, At, B1); PG8_BAR; PG8_SCHED;
            PG8_LDA(At, 0, 1); PG8_STAGE(PG8_SB(0, 0), b2, voffB); PG8_STAGE(PG8_SB(0, 1), b2 + hstep, voffB); PG8_STAGE(PG8_SA(0, 0), a2, voffA);
            PG8_WAIT_V(8); PG8_WAIT_L(0); PG8_BAR; PG8_MMA(1, 0, At, B0); PG8_MMA(1, 1, At, B1); PG8_BAR; PG8_SCHED;
            PG8_LDB(B0, 1, 0); PG8_LDB(B1, 1, 1); PG8_SCHED; PG8_LDA(At, 1, 0); PG8_STAGE(PG8_SA(0, 1), a2 + hstep, voffA);
            PG8_WAIT_V(8); PG8_WAIT_L(0); PG8_BAR; PG8_MMA(0, 0, At, B0); PG8_MMA(0, 1, At, B1); PG8_BAR; PG8_SCHED;
            PG8_LDA(At, 1, 1); PG8_STAGE(PG8_SB(1, 0), b3, voffB); PG8_STAGE(PG8_SB(1, 1), b3 + hstep, voffB); PG8_STAGE(PG8_SA(1, 0), a3, voffA);
            PG8_WAIT_V(8); PG8_WAIT_L(0); PG8_BAR; PG8_MMA(1, 0, At, B0); PG8_MMA(1, 1, At, B1); PG8_BAR; PG8_SCHED;
            } else {
            PG8_LDB(B0, 0, 0); PG8_SCHED; PG8_LDA(At, 0, 0); PG8_STAGE(PG8_SA(1, 1), a1 + hstep, voffA);
            PG8_WAIT_L(8); PG8_BAR; PG8_WAIT_L(0); PG8_MMA(0, 0, At, B0); PG8_BAR; PG8_SCHED;
            PG8_LDB(B1, 0, 1); PG8_STAGE(PG8_SB(0, 0), b2, voffB);
            PG8_BAR; PG8_WAIT_L(0); PG8_MMA(0, 1, At, B1); PG8_BAR;
            PG8_LDA(At, 0, 1); PG8_STAGE(PG8_SA(0, 0), a2, voffA);
            PG8_BAR; PG8_WAIT_L(0); PG8_MMA(1, 0, At, B0); PG8_BAR; PG8_SCHED;
            PG8_STAGE(PG8_SB(0, 1), b2 + hstep, voffB);
            PG8_WAIT_V(6); PG8_BAR; PG8_MMA(1, 1, At, B1); PG8_BAR;
            PG8_LDB(B0, 1, 0); PG8_SCHED; PG8_LDA(At, 1, 0); PG8_STAGE(PG8_SA(0, 1), a2 + hstep, voffA);
            PG8_WAIT_L(8); PG8_BAR; PG8_WAIT_L(0); PG8_MMA(0, 0, At, B0); PG8_BAR; PG8_SCHED;
            PG8_LDB(B1, 1, 1); PG8_STAGE(PG8_SB(1, 0), b3, voffB);
            PG8_BAR; PG8_WAIT_L(0); PG8_MMA(0, 1, At, B1); PG8_BAR;
            PG8_LDA(At, 1, 1); PG8_STAGE(PG8_SA(1, 0), a3, voffA);
            PG8_BAR; PG8_WAIT_L(0); PG8_MMA(1, 0, At, B0); PG8_BAR; PG8_SCHED;
            PG8_STAGE(PG8_SB(1, 1), b3 + hstep, voffB);
            PG8_WAIT_V(6); PG8_BAR; PG8_MMA(1, 1, At, B1); PG8_BAR;
            }
        }
        if constexpr (ALIGN_EPI) { if (wr == 0) PG8_BAR; }
        E(acc, cur, wr, wc, fr, fq);
        if (!has_next) break;
#pragma unroll
        for (int a = 0; a < 2; ++a)
#pragma unroll
            for (int b = 0; b < 2; ++b)
#pragma unroll
                for (int m = 0; m < 4; ++m)
#pragma unroll
                    for (int n = 0; n < 2; ++n) acc[a][b][m][n] = (f32x4){0.f, 0.f, 0.f, 0.f};
        cur = nxt; cA = nA; cB = nB; ++ui;
        if constexpr (ALIGN_EPI) { if (wr == 1) PG8_BAR; }
    }
    PG8_WAIT_V(0);
    if constexpr (!ALIGN_EPI) { if (wr == 0) PG8_BAR; }
    PG8_BAR;
#undef PG8_SA
#undef PG8_SB
#undef PG8_STAGE
#undef PG8_LDA
#undef PG8_LDB
#undef PG8_MMA
#undef PG8_WAIT_V
#undef PG8_WAIT_L
#undef PG8_BAR
#undef PG8_SCHED
}
}

using pg8::bf16_t; using pg8::bf16x8; using pg8::f32x4; using pg8::u32x4; using pg8::u32x2; using pg8::cvt_pk_bf16;
typedef float f32x16 __attribute__((ext_vector_type(16)));
typedef short s16x4 __attribute__((ext_vector_type(4)));
constexpr int NB = 8, SEQ = 4096, DM = 1024, MTOK = NB * SEQ;
constexpr int NHEAD = 8, HD = 64, DATT = 512, DSSM = 512, NGRP = 32, GCH = 16, NST = 64, DFF = 2816;
constexpr int PROJ_LD = 1536;
constexpr float EPS = 1e-6f;
constexpr int NWAVES = 8, NTHR = 512;
constexpr int LDS_BYTES = 147456;
constexpr int MISC_OFF = 147456 - 512;

constexpr size_t MiB = 1u << 20;
constexpr size_t WS_CTL = 0, CTL_ZERO_BYTES = 65536;
constexpr int CW_BAR = 4096;
constexpr size_t WS_WIN = 1 * MiB;
constexpr size_t WS_WGLU = 5 * MiB;
constexpr size_t WS_WOUT = 6 * MiB;
constexpr size_t WS_WGU = 8 * MiB;
constexpr size_t WS_WDN = 20 * MiB;
constexpr size_t WS_SSM = 26 * MiB;
constexpr size_t WS_LAM16 = 34 * MiB;
constexpr size_t WS_PART1 = 35 * MiB;
constexpr size_t WS_PART2 = 36 * MiB;
constexpr size_t WS_PART3 = 38 * MiB;
constexpr size_t WS_XN = 48 * MiB;
constexpr size_t WS_Z = 112 * MiB;
constexpr size_t WS_VT = 176 * MiB;
constexpr size_t WS_PROJ = 208 * MiB;
constexpr size_t WS_YG = 304 * MiB;
constexpr size_t WS_H = 176 * MiB;
constexpr size_t WS_END = 352 * MiB;

__device__ __forceinline__ int crow(int r, int hi) { return (r & 3) + 8 * (r >> 2) + 4 * hi; }
__device__ __forceinline__ float2 cmul(float2 a, float2 b) { return make_float2(a.x * b.x - a.y * b.y, a.x * b.y + a.y * b.x); }
__device__ __forceinline__ unsigned short bf1(float v) { return (unsigned short)(cvt_pk_bf16(v, v) & 0xffffu); }
__device__ __forceinline__ float wave_sum(float v) {
#pragma unroll
    for (int o = 1; o < 64; o <<= 1) v += __shfl_xor(v, o);
    return v;
}

struct Args {
    const float* x; const float* norm1_g; const float* w_in; const float* attn_norm_g; const float* lambda_re; const float* lambda_im; const float* log_step;
    const float* b_re; const float* b_im; const float* c_re; const float* c_im; const float* d_skip; const float* w_glu; const float* ssm_norm_g; const float* w_out;
    const float* norm2_g; const float* w_gate; const float* w_up; const float* w_down; const float* final_norm_g;
    float* out; unsigned char* ws;
};

__device__ __forceinline__ void transpose_item(const float* W, int N, bf16_t* WT, int ldt, int k0, int n0, int drow0, int dcol0, const float* gk, float* scr, int lane) {
#pragma unroll 8
    for (int i = 0; i < 32; ++i) { const int kk = 2 * i + (lane >> 5); float v = W[(size_t)(k0 + kk) * N + n0 + (lane & 31)]; if (gk) v *= gk[k0 + kk]; scr[kk * 33 + (lane & 31)] = v; }
    asm volatile("s_waitcnt lgkmcnt(0)" ::: "memory");
    const int c = lane & 7;
#pragma unroll
    for (int j = 0; j < 4; ++j) { const int n = (lane >> 3) + 8 * j; const float* s = scr + (8 * c) * 33 + n;
        u32x4 o; o.x = cvt_pk_bf16(s[0 * 33], s[1 * 33]); o.y = cvt_pk_bf16(s[2 * 33], s[3 * 33]); o.z = cvt_pk_bf16(s[4 * 33], s[5 * 33]); o.w = cvt_pk_bf16(s[6 * 33], s[7 * 33]);
        *(u32x4*)(WT + (size_t)(drow0 + n) * ldt + dcol0 + 8 * c) = o; }
    asm volatile("s_waitcnt lgkmcnt(0)" ::: "memory");
}

__device__ __forceinline__ void ssm_mats(const Args& A, int g, char* lds) {
    float2* lamp = (float2*)lds;
    float2* bbm = lamp + 17 * 64;
    float2* cm = bbm + 1024;
    float* Kt = (float*)(cm + 1024);
    float2* fb = (float2*)(Kt + 4096);
    const int tid = threadIdx.x;
    bf16_t* WstT = (bf16_t*)(A.ws + WS_SSM + (size_t)g * 262144); bf16_t* KinT = WstT + 128 * 256; bf16_t* WinT = KinT + 256 * 256;
    if (tid < 64) { const int p = tid; const float lr = A.lambda_re[g * 64 + p], li = A.lambda_im[g * 64 + p]; const float dt = expf(A.log_step[g]);
        const float mag = expf(lr * dt), ang = li * dt; const float lbr = mag * cosf(ang), lbi = mag * sinf(ang);
        const float den = lr * lr + li * li, nr = lbr - 1.0f; fb[p] = make_float2((nr * lr + lbi * li) / den, (lbi * lr - nr * li) / den);
        float2 pw = make_float2(1.f, 0.f); const float2 lb = make_float2(lbr, lbi);
        for (int k = 0; k <= 16; ++k) { lamp[k * 64 + p] = pw; pw = cmul(pw, lb); }
        ((float2*)(A.ws + WS_LAM16))[g * 64 + p] = lamp[16 * 64 + p]; }
    __syncthreads();
    for (int idx = tid; idx < 1024; idx += NTHR) { { const int p = idx >> 4, h = idx & 15; const float br = A.b_re[(size_t)(g * 64 + p) * 16 + h], bi = A.b_im[(size_t)(g * 64 + p) * 16 + h]; const float2 f = fb[p];
            bbm[idx] = make_float2(f.x * br - f.y * bi, f.x * bi + f.y * br); }
        { const int h = idx >> 6, p = idx & 63; cm[idx] = make_float2(A.c_re[(size_t)(g * 16 + h) * 64 + p], A.c_im[(size_t)(g * 16 + h) * 64 + p]); } }
    __syncthreads();
    for (int idx = tid; idx < 4096; idx += NTHR) { const int tau = idx >> 8, h = (idx >> 4) & 15, hp = idx & 15; float s = 0.f;
        for (int p = 0; p < 64; ++p) { const float2 cl = cmul(cm[h * 64 + p], lamp[tau * 64 + p]); const float2 bq = bbm[p * 16 + hp]; s += cl.x * bq.x - cl.y * bq.y; }
        if (tau == 0 && h == hp) s += A.d_skip[g * 16 + h];
        Kt[idx] = s; }
    __syncthreads();
    for (int ch = tid; ch < 8192; ch += NTHR) { const int n = ch >> 5, kc = ch & 31, t = n >> 4, h = n & 15, s = kc >> 1, hp0 = (kc & 1) * 8; float v[8];
#pragma unroll
        for (int e = 0; e < 8; ++e) v[e] = (s <= t) ? Kt[((t - s) * 16 + h) * 16 + hp0 + e] : 0.f;
        u32x4 o; o.x = cvt_pk_bf16(v[0], v[1]); o.y = cvt_pk_bf16(v[2], v[3]); o.z = cvt_pk_bf16(v[4], v[5]); o.w = cvt_pk_bf16(v[6], v[7]);
        *(u32x4*)(KinT + (size_t)n * 256 + kc * 8) = o; }
    for (int ch = tid; ch < 4096; ch += NTHR) { const int n = ch >> 5, kc = ch & 31, nb = n >> 5, j = n & 31, p = 32 * (nb >> 1) + j, part = nb & 1, s = kc >> 1, hp0 = (kc & 1) * 8; float v[8];
        const float2 l = lamp[(15 - s) * 64 + p];
#pragma unroll
        for (int e = 0; e < 8; ++e) { const float2 w = cmul(l, bbm[p * 16 + hp0 + e]); v[e] = part ? w.y : w.x; }
        u32x4 o; o.x = cvt_pk_bf16(v[0], v[1]); o.y = cvt_pk_bf16(v[2], v[3]); o.z = cvt_pk_bf16(v[4], v[5]); o.w = cvt_pk_bf16(v[6], v[7]);
        *(u32x4*)(WstT + (size_t)n * 256 + kc * 8) = o; }
    for (int ch = tid; ch < 4096; ch += NTHR) { const int n = ch >> 4, kc = ch & 15, t = n >> 4, h = n & 15; float v[8];
#pragma unroll
        for (int e = 0; e < 8; ++e) { const int k2 = kc * 8 + e, nb2 = k2 >> 5, j2 = k2 & 31, p = 32 * (nb2 >> 1) + j2, part = nb2 & 1;
            const float2 w = cmul(cm[h * 64 + p], lamp[(t + 1) * 64 + p]); v[e] = part ? -w.y : w.x; }
        u32x4 o; o.x = cvt_pk_bf16(v[0], v[1]); o.y = cvt_pk_bf16(v[2], v[3]); o.z = cvt_pk_bf16(v[4], v[5]); o.w = cvt_pk_bf16(v[6], v[7]);
        *(u32x4*)(WinT + (size_t)n * 128 + kc * 8) = o; }
    __syncthreads();
}

__device__ __forceinline__ void p0_prologue(const Args& A, char* lds, int G) {
    const int tid = threadIdx.x, lane = tid & 63, wave = tid >> 6;
    const int bx = blockIdx.x;
    for (int g = bx; g < NGRP; g += G) ssm_mats(A, g, lds);
    float* scr = (float*)(lds + wave * 16384);
    const int gw = bx * NWAVES + wave, NGW = G * NWAVES;
    bf16_t* Win_t = (bf16_t*)(A.ws + WS_WIN); bf16_t* Wglu_t = (bf16_t*)(A.ws + WS_WGLU); bf16_t* Wout_t = (bf16_t*)(A.ws + WS_WOUT);
    bf16_t* Wgu_t = (bf16_t*)(A.ws + WS_WGU); bf16_t* Wdn_t = (bf16_t*)(A.ws + WS_WDN);
    constexpr int I_IN = 16 * 64, I_GLU = 8 * 16, I_OUT = 16 * 32, I_G = 16 * 88, I_U = 16 * 88, I_D = 44 * 32;
    constexpr int NITEMS = I_IN + I_GLU + I_OUT + I_G + I_U + I_D;
    for (int it = gw; it < NITEMS; it += NGW) {
        int r = it;
        if (r < I_IN) { const int kb = r / 64, nb = r % 64, n0 = 32 * nb; const int drow0 = (n0 < 1024) ? n0 : (n0 < 1536 ? n0 + 512 : n0 - 512);
            transpose_item(A.w_in, 2048, Win_t, 1024, 64 * kb, n0, drow0, 64 * kb, nullptr, scr, lane); continue; } r -= I_IN;
        if (r < I_GLU) { const int kb = r / 16, nb = r % 16; transpose_item(A.w_glu, 512, Wglu_t, 512, 64 * kb, 32 * nb, 32 * nb, 64 * kb, nullptr, scr, lane); continue; } r -= I_GLU;
        if (r < I_OUT) { const int kb = r / 32, nb = r % 32, k0 = 64 * kb; const bool ssm = k0 >= 512;
            transpose_item(A.w_out, 1024, Wout_t, 1024, k0, 32 * nb, 32 * nb, ssm ? k0 - 512 : k0 + 512, ssm ? (A.ssm_norm_g - 512) : A.attn_norm_g, scr, lane); continue; } r -= I_OUT;
        if (r < I_G) { const int kb = r / 88, nb = r % 88, n0 = 32 * nb; transpose_item(A.w_gate, DFF, Wgu_t, 1024, 64 * kb, n0, 256 * (n0 / 128) + (n0 % 128), 64 * kb, A.norm2_g, scr, lane); continue; } r -= I_G;
        if (r < I_U) { const int kb = r / 88, nb = r % 88, n0 = 32 * nb; transpose_item(A.w_up, DFF, Wgu_t, 1024, 64 * kb, n0, 256 * (n0 / 128) + 128 + (n0 % 128), 64 * kb, A.norm2_g, scr, lane); continue; } r -= I_U;
        { const int kb = r / 32, nb = r % 32; transpose_item(A.w_down, 1024, Wdn_t, DFF, 64 * kb, 32 * nb, 32 * nb, 64 * kb, nullptr, scr, lane); }
    }
    bf16_t* XN = (bf16_t*)(A.ws + WS_XN);
    f32x4 gv[4];
#pragma unroll
    for (int j = 0; j < 4; ++j) gv[j] = ((const f32x4*)A.norm1_g)[lane + 64 * j];
    const int nskip = (G > 2 * NGRP) ? NGRP : 0;
    if (bx >= nskip) {
        const int gw2 = (bx - nskip) * NWAVES + wave, NGW2 = (G - nskip) * NWAVES;
        for (int m = gw2; m < MTOK; m += 2 * NGW2) {
            const int m1 = m + NGW2; const bool has1 = m1 < MTOK;
            const f32x4* xr0 = (const f32x4*)(A.x + (size_t)m * DM) + lane; const f32x4* xr1 = (const f32x4*)(A.x + (size_t)(has1 ? m1 : m) * DM) + lane;
            f32x4 v0[4], v1[4]; float s0 = 0.f, s1 = 0.f;
#pragma unroll
            for (int j = 0; j < 4; ++j) { v0[j] = xr0[64 * j]; v1[j] = xr1[64 * j]; }
#pragma unroll
            for (int j = 0; j < 4; ++j) { s0 += (v0[j][0] * v0[j][0] + v0[j][1] * v0[j][1]) + (v0[j][2] * v0[j][2] + v0[j][3] * v0[j][3]); s1 += (v1[j][0] * v1[j][0] + v1[j][1] * v1[j][1]) + (v1[j][2] * v1[j][2] + v1[j][3] * v1[j][3]); }
            const float rs0 = 1.0f / sqrtf(wave_sum(s0) * (1.0f / DM) + EPS), rs1 = 1.0f / sqrtf(wave_sum(s1) * (1.0f / DM) + EPS);
            u32x2* o0 = (u32x2*)(XN + (size_t)m * DM) + lane;
#pragma unroll
            for (int j = 0; j < 4; ++j) { u32x2 w; w.x = cvt_pk_bf16(v0[j][0] * rs0 * gv[j][0], v0[j][1] * rs0 * gv[j][1]); w.y = cvt_pk_bf16(v0[j][2] * rs0 * gv[j][2], v0[j][3] * rs0 * gv[j][3]); o0[64 * j] = w; }
            if (has1) { u32x2* o1 = (u32x2*)(XN + (size_t)m1 * DM) + lane;
#pragma unroll
                for (int j = 0; j < 4; ++j) { u32x2 w; w.x = cvt_pk_bf16(v1[j][0] * rs1 * gv[j][0], v1[j][1] * rs1 * gv[j][1]); w.y = cvt_pk_bf16(v1[j][2] * rs1 * gv[j][2], v1[j][3] * rs1 * gv[j][3]); o1[64 * j] = w; } }
        }
    }
}

__device__ __forceinline__ float gelu_tanh(float y) {
    const float u = 0.7978845608028654f * (y + 0.044715f * y * y * y);
    return y * __builtin_amdgcn_rcpf(1.0f + __builtin_amdgcn_exp2f(-2.0f * 1.4426950408889634f * u));
}
template <int NCHUNK_PER_THREAD, int ROWB, int DSTRIDE>
__device__ __forceinline__ void lds_fill(char* dst, const bf16_t* src, int tid) {
    u32x4 v[NCHUNK_PER_THREAD];
#pragma unroll
    for (int i = 0; i < NCHUNK_PER_THREAD; ++i) v[i] = ((const u32x4*)src)[tid + i * NTHR];
#pragma unroll
    for (int i = 0; i < NCHUNK_PER_THREAD; ++i) { const int c = tid + i * NTHR, row = c / (ROWB / 16), col = c % (ROWB / 16); *(u32x4*)(dst + row * DSTRIDE + col * 16) = v[i]; }
}
__device__ __forceinline__ void ssm_item(const Args& A, int b, int g, char* lds) {
    const int tid = threadIdx.x, lane = tid & 63, w = __builtin_amdgcn_readfirstlane(tid >> 6), j = lane & 31, hi = lane >> 5;
    char* R2 = lds;
    float2* E = (float2*)lds;
    bf16_t* XS = (bf16_t*)(lds + 65536);
    float2* SEG = (float2*)(lds + 65536 + 69632);
    const bf16_t* PROJ = (const bf16_t*)(A.ws + WS_PROJ);
    const bf16_t* WstT = (const bf16_t*)(A.ws + WS_SSM + (size_t)g * 262144); const bf16_t* KinT = WstT + 128 * 256; const bf16_t* WinT = KinT + 256 * 256;
    const float2* LAM16 = (const float2*)(A.ws + WS_LAM16);
    bf16_t* YG = (bf16_t*)(A.ws + WS_YG);
    bf16x8 ua[16];
    { const bf16_t* up = PROJ + ((size_t)(b * SEQ + 16 * (32 * w + j))) * PROJ_LD + 1024 + g * 16 + 8 * hi;
#pragma unroll
      for (int tl = 0; tl < 16; ++tl) ua[tl] = *(const bf16x8*)(up + (size_t)tl * PROJ_LD); }
#pragma unroll 1
    for (int hp = 0; hp < 2; ++hp) {
        lds_fill<4, 512, 528>(R2, WstT + (size_t)64 * hp * 256, tid);
        __syncthreads();
        f32x16 are = {}, aim = {};
        const char* bl = R2 + j * 528 + hi * 16;
#pragma unroll
        for (int ks = 0; ks < 16; ++ks) { const bf16x8 br = *(const bf16x8*)(bl + ks * 32), bi = *(const bf16x8*)(bl + 32 * 528 + ks * 32);
            are = __builtin_amdgcn_mfma_f32_32x32x16_bf16(ua[ks], br, are, 0, 0, 0); aim = __builtin_amdgcn_mfma_f32_32x32x16_bf16(ua[ks], bi, aim, 0, 0, 0); }
        __syncthreads();
#pragma unroll
        for (int r = 0; r < 16; ++r) E[(32 * w + crow(r, hi)) * 32 + j] = make_float2(are[r], aim[r]);
        __syncthreads();
        { const int seg = tid >> 5, pl = tid & 31; const float2 l16 = LAM16[g * 64 + 32 * hp + pl];
          float2 x = make_float2(0.f, 0.f);
#pragma unroll
          for (int i = 0; i < 16; ++i) { const float2 e = E[(16 * seg + i) * 32 + pl]; const float2 t = cmul(l16, x); x = make_float2(t.x + e.x, t.y + e.y); }
          SEG[seg * 32 + pl] = x;
          __syncthreads();
          float2 l256 = l16;
#pragma unroll
          for (int q = 0; q < 4; ++q) l256 = cmul(l256, l256);
          float2 xs = make_float2(0.f, 0.f);
          for (int s2 = 0; s2 < seg; ++s2) { const float2 e = SEG[s2 * 32 + pl]; const float2 t = cmul(l256, xs); xs = make_float2(t.x + e.x, t.y + e.y); }
          x = xs;
#pragma unroll
          for (int i = 0; i < 16; ++i) { const int c = 16 * seg + i; XS[c * 136 + 64 * hp + pl] = bf1(x.x); XS[c * 136 + 64 * hp + 32 + pl] = bf1(x.y);
              const float2 e = E[c * 32 + pl]; const float2 t = cmul(l16, x); x = make_float2(t.x + e.x, t.y + e.y); } }
        __syncthreads();
    }
#pragma unroll 1
    for (int qd = 0; qd < 4; ++qd) {
        lds_fill<4, 512, 528>(R2, KinT + (size_t)64 * qd * 256, tid);
        lds_fill<2, 256, 272>(R2 + 33792, WinT + (size_t)64 * qd * 128, tid);
        __syncthreads();
        f32x16 acc[2]; acc[0] = f32x16{}; acc[1] = f32x16{};
        const char* kl = R2 + j * 528 + hi * 16;
#pragma unroll
        for (int ks = 0; ks < 16; ++ks)
#pragma unroll
            for (int q = 0; q < 2; ++q) { if (ks <= 2 * (2 * qd + q) + 1) {
                    const bf16x8 bv = *(const bf16x8*)(kl + q * 32 * 528 + ks * 32); acc[q] = __builtin_amdgcn_mfma_f32_32x32x16_bf16(ua[ks], bv, acc[q], 0, 0, 0); } }
        const char* wl = R2 + 33792 + j * 272 + hi * 16;
#pragma unroll
        for (int k2 = 0; k2 < 8; ++k2) { const bf16x8 av = *(const bf16x8*)(XS + (32 * w + j) * 136 + 16 * k2 + 8 * hi);
#pragma unroll
            for (int q = 0; q < 2; ++q) { const bf16x8 bv = *(const bf16x8*)(wl + q * 32 * 272 + k2 * 32); acc[q] = __builtin_amdgcn_mfma_f32_32x32x16_bf16(av, bv, acc[q], 0, 0, 0); } }
#pragma unroll
        for (int q = 0; q < 2; ++q) { const int n = 64 * qd + 32 * q + j, t = n >> 4, h = n & 15;
#pragma unroll
            for (int r = 0; r < 16; ++r) { const int c = 32 * w + crow(r, hi); const int tok = 16 * c + t;
                YG[(size_t)(b * SEQ + tok) * DSSM + g * 16 + h] = bf1(gelu_tanh(acc[q][r])); } }
        __syncthreads();
    }
}

constexpr float ATT_SC = 0.125f * 1.4426950408889634f;
constexpr float ATT_STOP = 160.0f;
__device__ __forceinline__ void attn_item(const Args& A, int b, int qt, char* lds) {
    const int tid = threadIdx.x, lane = tid & 63, h = __builtin_amdgcn_readfirstlane(tid >> 6), j = lane & 31, hi = lane >> 5;
    float* OST = (float*)lds + h * (32 * 68);
    float* PART = (float*)(lds + 69632);
    const bf16_t* PROJ = (const bf16_t*)(A.ws + WS_PROJ);
    const bf16_t* VT = (const bf16_t*)(A.ws + WS_VT);
    bf16_t* Z = (bf16_t*)(A.ws + WS_Z);
    const int q0 = 32 * qt; const size_t rowbase = (size_t)b * SEQ;
    bf16x8 qf[4];
    { const bf16_t* qp = PROJ + (rowbase + q0 + j) * PROJ_LD + h * 64 + 8 * hi;
#pragma unroll
      for (int d0 = 0; d0 < 4; ++d0) qf[d0] = *(const bf16x8*)(qp + 16 * d0); }
    const bf16_t* kbase = PROJ + rowbase * PROJ_LD + 512 + h * 64 + 8 * hi;
    const bf16_t* vbase = VT + (size_t)(h * 64 + j) * MTOK + rowbase + 4 * hi;
    f32x16 o0 = {}, o1 = {}; float R2 = 0.f;
    bf16x8 kf[4]; s16x4 va[2][2], vb[2][2];
#define LOADKV(kt_) do { const int k0_ = 32 * (kt_); const bf16_t* kp_ = kbase + (size_t)(k0_ + j) * PROJ_LD; \
        _Pragma("unroll") for (int d0 = 0; d0 < 4; ++d0) kf[d0] = *(const bf16x8*)(kp_ + 16 * d0); \
        _Pragma("unroll") for (int db = 0; db < 2; ++db) _Pragma("unroll") for (int ks = 0; ks < 2; ++ks) { const bf16_t* vp_ = vbase + (size_t)db * 32 * MTOK + k0_ + 16 * ks; \
            va[db][ks] = *(const s16x4*)(vp_); vb[db][ks] = *(const s16x4*)(vp_ + 8); } } while (0)
    LOADKV(qt);
    for (int kt = qt; kt >= 0; --kt) {
        f32x16 s = {};
#pragma unroll
        for (int d0 = 0; d0 < 4; ++d0) s = __builtin_amdgcn_mfma_f32_32x32x16_bf16(kf[d0], qf[d0], s, 0, 0, 0);
        bf16x8 vf[2][2];
#pragma unroll
        for (int db = 0; db < 2; ++db)
#pragma unroll
            for (int ks = 0; ks < 2; ++ks) vf[db][ks] = (bf16x8){va[db][ks][0], va[db][ks][1], va[db][ks][2], va[db][ks][3], vb[db][ks][0], vb[db][ks][1], vb[db][ks][2], vb[db][ks][3]};
        if (kt > 0) LOADKV(kt - 1);
        const bool diag = (kt == qt);
        float L[16], z2[16];
#pragma unroll
        for (int r = 0; r < 16; ++r) { const float z = s[r] * ATT_SC; const float e = __builtin_amdgcn_exp2f(-fabsf(z));
            const float l = fmaxf(z, 0.f) + __builtin_amdgcn_logf(1.0f + e);
            const bool msk = diag && (crow(r, hi) >= j); L[r] = msk ? 0.f : l; z2[r] = msk ? -1e30f : z; }
        float gs[4], pg[4];
#pragma unroll
        for (int g4 = 0; g4 < 4; ++g4) { gs[g4] = (L[4 * g4] + L[4 * g4 + 1]) + (L[4 * g4 + 2] + L[4 * g4 + 3]); pg[g4] = __shfl_xor(gs[g4], 32); }
        float T[4]; T[3] = 0.f; T[2] = gs[3] + pg[3]; T[1] = T[2] + (gs[2] + pg[2]); T[0] = T[1] + (gs[1] + pg[1]);
        const float total = T[0] + (gs[0] + pg[0]);
        float wv[16];
#pragma unroll
        for (int g4 = 0; g4 < 4; ++g4) { const float after = T[g4] + (hi == 0 ? pg[g4] : 0.f) + R2;
            const float s3 = after, s2 = s3 + L[4 * g4 + 3], s1 = s2 + L[4 * g4 + 2], s0 = s1 + L[4 * g4 + 1];
            wv[4 * g4 + 3] = __builtin_amdgcn_exp2f(z2[4 * g4 + 3] - L[4 * g4 + 3] - s3);
            wv[4 * g4 + 2] = __builtin_amdgcn_exp2f(z2[4 * g4 + 2] - L[4 * g4 + 2] - s2);
            wv[4 * g4 + 1] = __builtin_amdgcn_exp2f(z2[4 * g4 + 1] - L[4 * g4 + 1] - s1);
            wv[4 * g4 + 0] = __builtin_amdgcn_exp2f(z2[4 * g4 + 0] - L[4 * g4 + 0] - s0); }
        R2 += total;
        u32x4 p0, p1;
        p0.x = cvt_pk_bf16(wv[0], wv[1]); p0.y = cvt_pk_bf16(wv[2], wv[3]); p0.z = cvt_pk_bf16(wv[4], wv[5]); p0.w = cvt_pk_bf16(wv[6], wv[7]);
        p1.x = cvt_pk_bf16(wv[8], wv[9]); p1.y = cvt_pk_bf16(wv[10], wv[11]); p1.z = cvt_pk_bf16(wv[12], wv[13]); p1.w = cvt_pk_bf16(wv[14], wv[15]);
        const bf16x8 pa0 = __builtin_bit_cast(bf16x8, p0), pa1 = __builtin_bit_cast(bf16x8, p1);
        o0 = __builtin_amdgcn_mfma_f32_32x32x16_bf16(pa0, vf[0][0], o0, 0, 0, 0); o0 = __builtin_amdgcn_mfma_f32_32x32x16_bf16(pa1, vf[0][1], o0, 0, 0, 0);
        o1 = __builtin_amdgcn_mfma_f32_32x32x16_bf16(pa0, vf[1][0], o1, 0, 0, 0); o1 = __builtin_amdgcn_mfma_f32_32x32x16_bf16(pa1, vf[1][1], o1, 0, 0, 0);
        if (__all(R2 > ATT_STOP)) break;
    }
#undef LOADKV
#pragma unroll
    for (int r = 0; r < 16; ++r) { OST[crow(r, hi) * 68 + j] = o0[r]; OST[crow(r, hi) * 68 + 32 + j] = o1[r]; }
    asm volatile("s_waitcnt lgkmcnt(0)" ::: "memory");
    f32x4 ov[8]; float ss = 0.f;
#pragma unroll
    for (int e = 0; e < 8; ++e) { ov[e] = *(const f32x4*)(OST + j * 68 + 32 * hi + 4 * e); ss += (ov[e][0] * ov[e][0] + ov[e][1] * ov[e][1]) + (ov[e][2] * ov[e][2] + ov[e][3] * ov[e][3]); }
    PART[(h * 32 + j) * 2 + hi] = ss;
    __syncthreads();
    float tot = 0.f;
#pragma unroll
    for (int w2 = 0; w2 < 8; ++w2) { tot += PART[(w2 * 32 + j) * 2] + PART[(w2 * 32 + j) * 2 + 1]; }
    const float rs = 1.0f / sqrtf(tot * (1.0f / DATT) + EPS);
    bf16_t* zp = Z + (rowbase + q0 + j) * 1024 + 512 + h * 64 + 32 * hi;
#pragma unroll
    for (int e = 0; e < 4; ++e) { const f32x4 a = ov[2 * e] * rs, c = ov[2 * e + 1] * rs; u32x4 w;
        w.x = cvt_pk_bf16(a[0], a[1]); w.y = cvt_pk_bf16(a[2], a[3]); w.z = cvt_pk_bf16(c[0], c[1]); w.w = cvt_pk_bf16(c[2], c[3]); *(u32x4*)(zp + 8 * e) = w; }
    __syncthreads();
}


#define LAS __attribute__((address_space(3)))
#define XB_TMO      128
#define XB_XCNT(j)  (256  + 64 * (j))
#define XB_XSUB(j)  (1280 + 64 * (j))
#define XB_XGEN(j)  (2304 + 64 * (j))
#define XB_TOP      3328
#define XB_TOPGEN   3392
#define XCD_BAR_WORDS 3456
#define XB_SPIN_CAP (1u << 18)
__device__ __forceinline__ unsigned xb_ld(unsigned* p)              { return __hip_atomic_load(p, __ATOMIC_RELAXED, __HIP_MEMORY_SCOPE_AGENT); }
__device__ __forceinline__ unsigned xb_add(unsigned* p, unsigned v) { return __hip_atomic_fetch_add(p, v, __ATOMIC_RELAXED, __HIP_MEMORY_SCOPE_AGENT); }
__device__ __forceinline__ unsigned xb_xcc_id() { return (unsigned)__builtin_amdgcn_s_getreg((3 << 11) | 20) & 0xFu; }
#define XB_SPIN(cond, bar) do { unsigned _sp = 0; while (cond) { __builtin_amdgcn_s_sleep(1); \
    if ((++_sp & 255u) == 0u) { if (xb_ld(&(bar)[XB_TMO])) break; if (_sp > XB_SPIN_CAP) { atomicAdd(&(bar)[XB_TMO], 1u); break; } } } } while (0)
struct XcdBarrier { unsigned* bar; unsigned x; volatile LAS unsigned* st; };
__device__ __forceinline__ XcdBarrier xcd_barrier_post(unsigned* bar, volatile LAS unsigned* st) {
    XcdBarrier b; b.bar = bar; b.x = xb_xcc_id(); b.st = st;
    if (threadIdx.x == 0) (void)xb_add(&bar[XB_XCNT(b.x)], 1u);
    return b;
}
__device__ __forceinline__ void xcd_barrier_complete(unsigned* bar, unsigned x, unsigned& nloc, unsigned& nx) {
    const unsigned G = gridDim.x * gridDim.y * gridDim.z;
    unsigned sum, cnt, mine, sp = 0u;
    for (;;) {
        sum = 0u; cnt = 0u; mine = 0u;
#pragma unroll
        for (unsigned j = 0; j < 16; ++j) { const unsigned c = xb_ld(&bar[XB_XCNT(j)]); sum += c; cnt += (c > 0u) ? 1u : 0u; mine = (j == x) ? c : mine; }
        if (sum == G) break;
        __builtin_amdgcn_s_sleep(1);
        if ((++sp & 255u) == 0u) { if (xb_ld(&bar[XB_TMO])) break; if (sp > XB_SPIN_CAP) { atomicAdd(&bar[XB_TMO], 1u); break; } }
    }
    nloc = mine > 0u ? mine : 1u; nx = cnt > 0u ? cnt : 1u;
}
__device__ __forceinline__ void xcd_barrier(const XcdBarrier& b) {
    asm volatile("s_waitcnt vmcnt(0)" ::: "memory");
    __syncthreads();
    if (threadIdx.x == 0) {
        unsigned* bar = b.bar;
        __builtin_amdgcn_s_waitcnt(0);
        unsigned nloc = b.st[0], nx = b.st[1];
        if (nloc == 0u) { xcd_barrier_complete(bar, b.x, nloc, nx); b.st[0] = nloc; b.st[1] = nx; }
        const unsigned old = xb_add(&bar[XB_XSUB(b.x)], 1u);
        const unsigned gen = old / nloc;
        if (old + 1u == (gen + 1u) * nloc) {
            __builtin_amdgcn_fence(__ATOMIC_RELEASE, "agent");
            asm volatile("s_waitcnt vmcnt(0)" ::: "memory");
            const unsigned og = xb_add(&bar[XB_TOP], 1u);
            const unsigned tg = og / nx;
            if (og + 1u == (tg + 1u) * nx) xb_add(&bar[XB_TOPGEN], 1u);
            else XB_SPIN(xb_ld(&bar[XB_TOPGEN]) == tg, bar);
            __builtin_amdgcn_fence(__ATOMIC_ACQUIRE, "agent");
            xb_add(&bar[XB_XGEN(b.x)], 1u);
            asm volatile("s_waitcnt vmcnt(0)" ::: "memory");
        } else {
            XB_SPIN(xb_ld(&bar[XB_XGEN(b.x)]) == gen, bar);
            __builtin_amdgcn_fence(__ATOMIC_ACQUIRE, "agent");
            asm volatile("s_waitcnt vmcnt(0)" ::: "memory");
        }
    }
    __syncthreads();
}

__global__ void __launch_bounds__(NTHR, 2) hymba_fwd(Args A) {
    extern __shared__ __attribute__((aligned(16))) unsigned char lds[];
    cg::grid_group grid = cg::this_grid();
    const int G = gridDim.x, bx = blockIdx.x;
    PG8_LAS unsigned char* lds3 = (PG8_LAS unsigned char*)lds;
    volatile LAS unsigned* MISC = (volatile LAS unsigned*)(lds3 + MISC_OFF);
    if (threadIdx.x < 32) MISC[threadIdx.x] = 0u;
    __syncthreads();
    XcdBarrier bar = xcd_barrier_post((unsigned*)(A.ws + WS_CTL) + CW_BAR, MISC + 8);
#ifdef PROBE_A
    volatile LAS unsigned long long* STAMP = (volatile LAS unsigned long long*)(lds3 + MISC_OFF + 128);
#define STAMPIT(i) do { if (threadIdx.x == 0) STAMP[i] = __builtin_amdgcn_s_memrealtime(); } while (0)
#else
#define STAMPIT(i) do {} while (0)
#endif
    STAMPIT(0);

#ifndef NO_P0
    p0_prologue(A, (char*)lds, G);
#endif
    if (A.ws == nullptr) grid.sync();
    xcd_barrier(bar);
    STAMPIT(1);

#ifndef NO_P1
    {
        pg8::Gemm g{(const bf16_t*)(A.ws + WS_XN), (const bf16_t*)(A.ws + WS_WIN), MTOK, 1536, DM}; pg8::StaticOrder S; S.init(MTOK, 1536, G, bx);
        pg8::EpiStore E{(bf16_t*)(A.ws + WS_PROJ), PROJ_LD};
        pg8::gemm_phase<pg8::EpiStore, pg8::StaticOrder, true, true, false>(lds3, g, S, E, nullptr, 0.f);
        pg8::Gemm g2{(const bf16_t*)(A.ws + WS_WIN) + (size_t)1536 * DM, (const bf16_t*)(A.ws + WS_XN), 512, MTOK, DM}; pg8::StaticOrder S2; S2.init(512, MTOK, G, bx);
        pg8::EpiStore E2{(bf16_t*)(A.ws + WS_VT), MTOK};
        pg8::gemm_phase<pg8::EpiStore, pg8::StaticOrder, true, true, false>(lds3, g2, S2, E2, nullptr, 0.f);
    }
#endif
    xcd_barrier(bar);
    STAMPIT(2);

#ifndef NO_SSM
    for (int it = bx; it < NB * NGRP; it += G) ssm_item(A, it >> 5, it & 31, (char*)lds);
#endif
    STAMPIT(9);
#ifndef NO_ATT
    for (int it = bx; it < NB * (SEQ / 32); it += G) attn_item(A, it >> 7, it & 127, (char*)lds);
#endif
    xcd_barrier(bar);
    STAMPIT(3);

#ifndef NO_P3
    {
        pg8::Gemm g{(const bf16_t*)(A.ws + WS_YG), (const bf16_t*)(A.ws + WS_WGLU), MTOK, 512, 512}; pg8::StaticOrder S; S.init(MTOK, 512, G, bx);
        pg8::EpiGlu E{(const bf16_t*)(A.ws + WS_YG), (bf16_t*)(A.ws + WS_Z), (float*)(A.ws + WS_PART1)};
        pg8::gemm_phase<pg8::EpiGlu, pg8::StaticOrder, true, true, false>(lds3, g, S, E, nullptr, 0.f);
    }
#endif
    xcd_barrier(bar);
    STAMPIT(4);

#ifndef NO_P4
    {
        pg8::Gemm g{(const bf16_t*)(A.ws + WS_Z), (const bf16_t*)(A.ws + WS_WOUT), MTOK, DM, DM}; pg8::StaticOrder S; S.init(MTOK, DM, G, bx);
        pg8::EpiRes E{A.x, A.out, (bf16_t*)(A.ws + WS_XN), (float*)(A.ws + WS_PART2)};
        pg8::gemm_phase<pg8::EpiRes, pg8::StaticOrder, true, true, true>(lds3, g, S, E, (const float*)(A.ws + WS_PART1), EPS);
    }
#endif
    xcd_barrier(bar);
    STAMPIT(5);

#ifndef NO_P5
    {
        pg8::Gemm g{(const bf16_t*)(A.ws + WS_XN), (const bf16_t*)(A.ws + WS_WGU), MTOK, 2 * DFF, DM}; pg8::StaticOrder S; S.init(MTOK, 2 * DFF, G, bx);
        pg8::EpiGateUp E{(bf16_t*)(A.ws + WS_H), (const float*)(A.ws + WS_PART2), EPS};
        pg8::gemm_phase<pg8::EpiGateUp, pg8::StaticOrder, true, true, false>(lds3, g, S, E, nullptr, 0.f);
    }
#endif
    xcd_barrier(bar);
    STAMPIT(6);

#ifndef NO_P6
    {
        pg8::Gemm g{(const bf16_t*)(A.ws + WS_H), (const bf16_t*)(A.ws + WS_WDN), MTOK, DM, DFF}; pg8::StaticOrder S; S.init(MTOK, DM, G, bx);
        pg8::EpiRes E{A.out, A.out, nullptr, (float*)(A.ws + WS_PART3)};
        pg8::gemm_phase<pg8::EpiRes, pg8::StaticOrder, true, true, false>(lds3, g, S, E, nullptr, 0.f);
    }
#endif
    xcd_barrier(bar);
    STAMPIT(7);

    {
        int tid7 = threadIdx.x; asm volatile("" : "+v"(tid7));
        const int wave = tid7 >> 6, lane = tid7 & 63;
        const int gw = bx * NWAVES + wave, NGW = G * NWAVES;
        f32x4 gv[4];
#pragma unroll
        for (int j = 0; j < 4; ++j) gv[j] = ((const f32x4*)A.final_norm_g)[lane + 64 * j];
        const float* part = (const float*)(A.ws + WS_PART3);
        for (int m = gw; m < MTOK; m += NGW) {
            const f32x4* pp = (const f32x4*)(part + (size_t)m * 16); const f32x4 p0 = pp[0], p1 = pp[1], p2 = pp[2], p3 = pp[3];
            const float s = ((p0[0] + p0[1]) + (p0[2] + p0[3])) + ((p1[0] + p1[1]) + (p1[2] + p1[3])) + ((p2[0] + p2[1]) + (p2[2] + p2[3])) + ((p3[0] + p3[1]) + (p3[2] + p3[3]));
            const float rs = 1.0f / sqrtf(s * (1.0f / DM) + EPS);
            f32x4* xr = (f32x4*)(A.out + (size_t)m * DM) + lane;
#pragma unroll
            for (int j = 0; j < 4; ++j) { const f32x4 v = xr[64 * j]; xr[64 * j] = v * rs * gv[j]; }
        }
    }
#ifdef PROBE_A
    STAMPIT(8);
    if (bx == 0 && threadIdx.x == 0) { const unsigned long long dt = STAMP[PROBE_B] - STAMP[PROBE_A]; const unsigned long long t0 = __builtin_amdgcn_s_memrealtime(); while (__builtin_amdgcn_s_memrealtime() - t0 < dt) __builtin_amdgcn_s_sleep(8); }
#endif
}

extern "C" void kernel_launch(void* const* d_in, const int* in_sizes, int n_in, void* d_out, int out_size, void* d_ws, size_t ws_size, hipStream_t stream) {
    static int grid = 0;
    if (grid == 0) {
        if (n_in != 20 || in_sizes[0] != MTOK * DM || out_size != MTOK * DM || ws_size < WS_END) { fprintf(stderr, "kernel_launch: unexpected problem shape / workspace (%d inputs, ws %zu)\n", n_in, ws_size); grid = -1; return; }
        int dev = 0, cus = 0, per_cu = 0;
        if (hipGetDevice(&dev) != hipSuccess || hipDeviceGetAttribute(&cus, hipDeviceAttributeMultiprocessorCount, dev) != hipSuccess) { grid = -1; return; }
        if (hipFuncSetAttribute((const void*)hymba_fwd, hipFuncAttributeMaxDynamicSharedMemorySize, LDS_BYTES) != hipSuccess) { fprintf(stderr, "kernel_launch: hipFuncSetAttribute failed\n"); grid = -1; return; }
        if (hipOccupancyMaxActiveBlocksPerMultiprocessor(&per_cu, (const void*)hymba_fwd, NTHR, LDS_BYTES) != hipSuccess || per_cu < 1) { fprintf(stderr, "kernel_launch: occupancy query says %d\n", per_cu); per_cu = 1; }
        (void)hipGetLastError();
        grid = cus * 1;
    }
    if (grid < 0) return;
    if (hipMemsetAsync((char*)d_ws + WS_CTL, 0, CTL_ZERO_BYTES, stream) != hipSuccess) { fprintf(stderr, "kernel_launch: memset failed\n"); return; }
    Args a{};
    const float** f = (const float**)&a;
    for (int i = 0; i < 20; ++i) f[i] = (const float*)d_in[i];
    a.out = (float*)d_out; a.ws = (unsigned char*)d_ws;
    void* args[] = {&a};
    hipError_t e = hipLaunchCooperativeKernel((const void*)hymba_fwd, dim3(grid), dim3(NTHR), args, LDS_BYTES, stream);
    if (e != hipSuccess) fprintf(stderr, "cooperative launch failed: %s (grid %d)\n", hipGetErrorString(e), grid);
}
```

```cpp
#include <hip/hip_runtime.h>
#include <hip/hip_cooperative_groups.h>
#include <cstdio>
#include <cstdint>
namespace cg = cooperative_groups;

namespace pg8 {
#define PG8_LAS __attribute__((address_space(3)))
typedef unsigned short bf16_t;
typedef short bf16x8 __attribute__((ext_vector_type(8)));
typedef float f32x4 __attribute__((ext_vector_type(4)));
typedef float f32x2 __attribute__((ext_vector_type(2)));
typedef unsigned u32x4 __attribute__((ext_vector_type(4)));
typedef unsigned u32x2 __attribute__((ext_vector_type(2)));
constexpr int BM = 256, BK = 64, HALF = 128, HTB = HALF * BK * 2, STAGE_BYTES = 8 * HTB, NXCD = 8, WGM = 8;

__host__ __device__ __forceinline__ int lds_byte(int r, int c) { const int st = (r >> 4) * 2 + (c >> 5), rr = r & 15, cc = c & 31, ob = rr * 64 + cc * 2; return st * 1024 + (ob ^ (((ob >> 9) & 1) << 5)); }
__host__ __device__ __forceinline__ void stage_rc(int b, int& R, int& C) { const int st = b / 1024, sb = b % 1024, swz = sb ^ (((sb >> 9) & 1) << 5); R = (st >> 1) * 16 + swz / 64; C = (st & 1) * 32 + (swz % 64) / 2; }
__host__ __device__ __forceinline__ int perm32(int rho) { const int n = rho >> 4, i = rho & 15; return 8 * (i >> 2) + 4 * n + (i & 3); }

struct Unit { int pm, pn; };
struct Gemm { const bf16_t* A; const bf16_t* Bt; int M, N, K; };

struct StaticOrder {
    int nM, nN, nwg, G, c;
    __host__ __device__ void init(int M, int N, int G_, int c_) { nM = M / BM; nN = N / BM; nwg = nM * nN; G = G_; c = c_; }
    __host__ __device__ bool next(int i, Unit& u) const {
        const long L = (long)i * G + c; if (L >= nwg) return false;
        int wgid = (int)L; { const int q = nwg / NXCD, r = nwg % NXCD, xcd = wgid % NXCD, off = wgid / NXCD; wgid = (xcd < r ? xcd * (q + 1) : r * (q + 1) + (xcd - r) * q) + off; }
        const int nig = WGM * nN, gid = wgid / nig, fm = gid * WGM, gsz = (nM - fm) < WGM ? (nM - fm) : WGM;
        u.pm = fm + ((wgid % nig) % gsz); u.pn = (wgid % nig) / gsz; return true;
    }
    __device__ __forceinline__ void a_ready(const Unit&) const {}
    __device__ __forceinline__ void done(const Unit&) const {}
};

__device__ __forceinline__ unsigned cvt_pk_bf16(float lo, float hi) { unsigned r; asm volatile("v_cvt_pk_bf16_f32 %0, %1, %2" : "=v"(r) : "v"(lo), "v"(hi)); return r; }
__device__ __forceinline__ float bf_lo(unsigned w) { return __uint_as_float(w << 16); }
__device__ __forceinline__ float bf_hi(unsigned w) { return __uint_as_float(w & 0xffff0000u); }

struct EpiStore {
    static constexpr bool PERM = true;
    bf16_t* O; int ldc;
    __device__ __forceinline__ void operator()(const f32x4 (&acc)[2][2][4][2], const Unit& u, int wr, int wc, int fr, int fq) const {
        asm volatile("" : "+v"(fr), "+v"(fq));
        const int row0 = u.pm * BM + wr * 64 + fr, col0 = u.pn * BM + wc * 32 + 8 * fq;
#pragma unroll
        for (int ai = 0; ai < 2; ++ai)
#pragma unroll
            for (int m = 0; m < 4; ++m) { bf16_t* rowp = O + (size_t)(row0 + ai * HALF + m * 16) * ldc + col0;
#pragma unroll
                for (int bj = 0; bj < 2; ++bj) { const f32x4 v0 = acc[ai][bj][m][0], v1 = acc[ai][bj][m][1];
                    u32x4 w; w.x = cvt_pk_bf16(v0[0], v0[1]); w.y = cvt_pk_bf16(v0[2], v0[3]); w.z = cvt_pk_bf16(v1[0], v1[1]); w.w = cvt_pk_bf16(v1[2], v1[3]);
                    *(u32x4*)(rowp + bj * HALF) = w; } }
    }
};
__device__ __forceinline__ float sigmoidf_fast(float a) { return __builtin_amdgcn_rcpf(1.0f + __builtin_amdgcn_exp2f(-1.4426950408889634f * a)); }
struct EpiGlu {
    static constexpr bool PERM = true;
    const bf16_t* Y; bf16_t* Z; float* part;
    __device__ __forceinline__ void operator()(const f32x4 (&acc)[2][2][4][2], const Unit& u, int wr, int wc, int fr, int fq) const {
        asm volatile("" : "+v"(fr), "+v"(fq));
        const int row0 = u.pm * BM + wr * 64 + fr, col0 = u.pn * BM + wc * 32 + 8 * fq;
#pragma unroll
        for (int ai = 0; ai < 2; ++ai)
#pragma unroll
            for (int m = 0; m < 4; ++m) { const int row = row0 + ai * HALF + m * 16; float ss = 0.f;
#pragma unroll
                for (int bj = 0; bj < 2; ++bj) { const int col = col0 + bj * HALF;
                    const u32x4 yv = *(const u32x4*)(Y + (size_t)row * 512 + col);
                    const f32x4 a0 = acc[ai][bj][m][0], a1 = acc[ai][bj][m][1];
                    float v[8];
                    v[0] = bf_lo(yv.x) * sigmoidf_fast(a0[0]); v[1] = bf_hi(yv.x) * sigmoidf_fast(a0[1]);
                    v[2] = bf_lo(yv.y) * sigmoidf_fast(a0[2]); v[3] = bf_hi(yv.y) * sigmoidf_fast(a0[3]);
                    v[4] = bf_lo(yv.z) * sigmoidf_fast(a1[0]); v[5] = bf_hi(yv.z) * sigmoidf_fast(a1[1]);
                    v[6] = bf_lo(yv.w) * sigmoidf_fast(a1[2]); v[7] = bf_hi(yv.w) * sigmoidf_fast(a1[3]);
#pragma unroll
                    for (int e = 0; e < 8; ++e) ss += v[e] * v[e];
                    u32x4 w; w.x = cvt_pk_bf16(v[0], v[1]); w.y = cvt_pk_bf16(v[2], v[3]); w.z = cvt_pk_bf16(v[4], v[5]); w.w = cvt_pk_bf16(v[6], v[7]);
                    *(u32x4*)(Z + (size_t)row * 1024 + col) = w; }
                ss += __shfl_xor(ss, 16); ss += __shfl_xor(ss, 32);
                if (fq == 0) part[(size_t)row * 8 + u.pn * 4 + wc] = ss; asm volatile("" ::: "memory"); }
    }
};
struct EpiRes {
    static constexpr bool PERM = false;
    const float* base; float* out; bf16_t* xb; float* part;
    __device__ __forceinline__ void operator()(const f32x4 (&acc)[2][2][4][2], const Unit& u, int wr, int wc, int fr, int fq) const {
        asm volatile("" : "+v"(fr), "+v"(fq));
        const int row0 = u.pm * BM + wr * 64 + fr, col0 = u.pn * BM + wc * 32 + 4 * fq;
#pragma unroll
        for (int ai = 0; ai < 2; ++ai) {
            f32x4 bv[4][2][2];
#pragma unroll
            for (int m = 0; m < 4; ++m) { const size_t off = (size_t)(row0 + ai * HALF + m * 16) * 1024 + col0;
#pragma unroll
                for (int bj = 0; bj < 2; ++bj)
#pragma unroll
                    for (int n = 0; n < 2; ++n) bv[m][bj][n] = *(const f32x4*)(base + off + bj * HALF + n * 16); }
#pragma unroll
            for (int m = 0; m < 4; ++m) { const int row = row0 + ai * HALF + m * 16; float ss = 0.f; const size_t off = (size_t)row * 1024 + col0;
#pragma unroll
                for (int bj = 0; bj < 2; ++bj)
#pragma unroll
                    for (int n = 0; n < 2; ++n) { const size_t o2 = off + bj * HALF + n * 16;
                        const f32x4 v = bv[m][bj][n] + acc[ai][bj][m][n];
                        *(f32x4*)(out + o2) = v; ss += (v[0] * v[0] + v[1] * v[1]) + (v[2] * v[2] + v[3] * v[3]);
                        if (xb) { u32x2 w; w.x = cvt_pk_bf16(v[0], v[1]); w.y = cvt_pk_bf16(v[2], v[3]); *(u32x2*)(xb + o2) = w; } }
                ss += __shfl_xor(ss, 16); ss += __shfl_xor(ss, 32);
                if (fq == 0) part[(size_t)row * 16 + u.pn * 4 + wc] = ss; }
            asm volatile("" ::: "memory");
        }
    }
};
struct EpiGateUp {
    static constexpr bool PERM = true;
    bf16_t* H; const float* part; float eps;
    __device__ __forceinline__ void operator()(const f32x4 (&acc)[2][2][4][2], const Unit& u, int wr, int wc, int fr, int fq) const {
        asm volatile("" : "+v"(fr), "+v"(fq));
        const int row0 = u.pm * BM + wr * 64 + fr, col0 = u.pn * HALF + wc * 32 + 8 * fq;
#pragma unroll
        for (int ai = 0; ai < 2; ++ai)
#pragma unroll
            for (int m = 0; m < 4; ++m) { const int row = row0 + ai * HALF + m * 16;
                const f32x4* pp = (const f32x4*)(part + (size_t)row * 16); const f32x4 p0 = pp[0], p1 = pp[1], p2 = pp[2], p3 = pp[3];
                const float s = ((p0[0] + p0[1]) + (p0[2] + p0[3])) + ((p1[0] + p1[1]) + (p1[2] + p1[3])) + ((p2[0] + p2[1]) + (p2[2] + p2[3])) + ((p3[0] + p3[1]) + (p3[2] + p3[3]));
                const float rs = 1.0f / sqrtf(s * (1.0f / 1024.0f) + eps);
                float v[8];
#pragma unroll
                for (int n = 0; n < 2; ++n)
#pragma unroll
                    for (int e = 0; e < 4; ++e) { const float g = acc[ai][0][m][n][e] * rs, up = acc[ai][1][m][n][e] * rs; v[n * 4 + e] = g * sigmoidf_fast(g) * up; }
                u32x4 w; w.x = cvt_pk_bf16(v[0], v[1]); w.y = cvt_pk_bf16(v[2], v[3]); w.z = cvt_pk_bf16(v[4], v[5]); w.w = cvt_pk_bf16(v[6], v[7]);
                *(u32x4*)(H + (size_t)row * 2816 + col0) = w; if (m & 1) asm volatile("" ::: "memory"); }
    }
};

template <class Epi, class Sched, bool ALIGN_EPI, bool SP2, bool MID>
__device__ __forceinline__ void gemm_phase(PG8_LAS unsigned char* lds, const Gemm g, const Sched& S, const Epi& E, const float* midp, float mid_eps) {
    int tid = threadIdx.x; asm volatile("" : "+v"(tid));
    const int wid = __builtin_amdgcn_readfirstlane(tid >> 6), lane = tid & 63, wr = wid >> 2, wc = wid & 3, fr = lane & 15, fq = lane >> 4;
    const int K = g.K, nt = K / BK;
    unsigned voffA[2], voffB[2];
#pragma unroll
    for (int i = 0; i < 2; ++i) { int R, C; stage_rc(tid * 16 + i * 8192, R, C); const int Rb = Epi::PERM ? ((R & ~31) + perm32(R & 31)) : R;
        voffA[i] = (unsigned)(R * K + C) * 2u; voffB[i] = (unsigned)(Rb * K + C) * 2u; }
    const size_t kstep = (size_t)(BK * 2);
    const size_t hstep = (size_t)HALF * K * 2;
    const size_t tstep = 2 * hstep;
    const unsigned ldsw = (unsigned)wid * 1024u;
    const int aoff = lds_byte(wr * 64 + fr, fq * 8), boff = lds_byte(wc * 32 + fr, fq * 8);
#define PG8_SA(b, h) (((b) * 2 + (h)) * HTB)
#define PG8_SB(b, h) ((4 + (b) * 2 + (h)) * HTB)
#define PG8_STAGE(bufoff, gbase, voff) do { _Pragma("unroll") for (int _i = 0; _i < 2; ++_i) \
        __builtin_amdgcn_global_load_lds((const unsigned*)((const char*)(gbase) + (voff)[_i]), (PG8_LAS unsigned*)(lds + (bufoff) + ldsw + _i * 8192), 16, 0, 0); } while (0)
#define PG8_LDA(dst, b, h) do { _Pragma("unroll") for (int m = 0; m < 4; ++m) _Pragma("unroll") for (int k = 0; k < 2; ++k) dst[m][k] = *(const PG8_LAS bf16x8*)(lds + PG8_SA(b, h) + aoff + m * 2048 + k * 1024); } while (0)
#define PG8_LDB(dst, b, h) do { _Pragma("unroll") for (int n = 0; n < 2; ++n) _Pragma("unroll") for (int k = 0; k < 2; ++k) dst[n][k] = *(const PG8_LAS bf16x8*)(lds + PG8_SB(b, h) + boff + n * 2048 + k * 1024); } while (0)
#define PG8_MMA(ai, bj, At, Bt) do { __builtin_amdgcn_s_setprio(1); _Pragma("unroll") for (int m = 0; m < 4; ++m) _Pragma("unroll") for (int n = 0; n < 2; ++n) _Pragma("unroll") for (int k = 0; k < 2; ++k) \
        acc[ai][bj][m][n] = __builtin_amdgcn_mfma_f32_16x16x32_bf16(Bt[n][k], At[m][k], acc[ai][bj][m][n], 0, 0, 0); __builtin_amdgcn_s_setprio(0); } while (0)
#define PG8_WAIT_V(n) asm volatile("s_waitcnt vmcnt(" #n ")" ::: "memory")
#define PG8_WAIT_L(n) asm volatile("s_waitcnt lgkmcnt(" #n ")" ::: "memory")
#define PG8_BAR __builtin_amdgcn_s_barrier()
#define PG8_SCHED __builtin_amdgcn_sched_barrier(0)
    Unit cur, nxt; int ui = 0;
    if (!S.next(0, cur)) return;
    f32x4 acc[2][2][4][2];
#pragma unroll
    for (int a = 0; a < 2; ++a)
#pragma unroll
        for (int b = 0; b < 2; ++b)
#pragma unroll
            for (int m = 0; m < 4; ++m)
#pragma unroll
                for (int n = 0; n < 2; ++n) acc[a][b][m][n] = (f32x4){0.f, 0.f, 0.f, 0.f};
    bf16x8 At[4][2], B0[2][2], B1[2][2];
    const char* cA = (const char*)g.A + (size_t)cur.pm * tstep; const char* cB = (const char*)g.Bt + (size_t)cur.pn * tstep;
    if constexpr (SP2) {
        PG8_STAGE(PG8_SB(0, 0), cB, voffB); PG8_STAGE(PG8_SB(0, 1), cB + hstep, voffB); PG8_STAGE(PG8_SA(0, 0), cA, voffA); PG8_STAGE(PG8_SA(0, 1), cA + hstep, voffA);
        if (wr == 1) PG8_BAR;
        PG8_WAIT_V(2); PG8_BAR;
        PG8_STAGE(PG8_SB(1, 0), cB + kstep, voffB); PG8_STAGE(PG8_SA(1, 0), cA + kstep, voffA); PG8_STAGE(PG8_SB(1, 1), cB + hstep + kstep, voffB);
        PG8_WAIT_V(6); PG8_BAR;
    } else {
        PG8_STAGE(PG8_SB(0, 0), cB, voffB); PG8_STAGE(PG8_SA(0, 0), cA, voffA); PG8_STAGE(PG8_SB(0, 1), cB + hstep, voffB); PG8_STAGE(PG8_SA(0, 1), cA + hstep, voffA);
        if (wr == 1) PG8_BAR;
        PG8_WAIT_V(4); PG8_BAR;
        PG8_STAGE(PG8_SB(1, 0), cB + kstep, voffB); PG8_STAGE(PG8_SA(1, 0), cA + kstep, voffA); PG8_STAGE(PG8_SB(1, 1), cB + hstep + kstep, voffB);
        PG8_WAIT_V(6); PG8_BAR;
    }
    for (;;) {
        const bool has_next = S.next(ui + 1, nxt);
        const char* nA = has_next ? (const char*)g.A + (size_t)nxt.pm * tstep : cA; const char* nB = has_next ? (const char*)g.Bt + (size_t)nxt.pn * tstep : cB;
        for (int t = 0; t < nt; t += 2) {
            const bool last = (t == nt - 2);
            const char* a1 = cA + (size_t)(t + 1) * kstep;
            const char* a2 = last ? nA : cA + (size_t)(t + 2) * kstep; const char* b2 = last ? nB : cB + (size_t)(t + 2) * kstep;
            const char* a3 = a2 + kstep; const char* b3 = b2 + kstep;
            if constexpr (MID) {
                if (t == (nt >> 1)) {
                    PG8_SCHED;
#pragma unroll
                    for (int ai = 0; ai < 2; ++ai)
#pragma unroll
                        for (int m = 0; m < 4; ++m) { const int row = cur.pm * BM + ai * HALF + wr * 64 + m * 16 + fr;
                            const f32x4 p0 = *(const f32x4*)(midp + (size_t)row * 8), p1 = *(const f32x4*)(midp + (size_t)row * 8 + 4);
                            const float s = ((p0[0] + p0[1]) + (p0[2] + p0[3])) + ((p1[0] + p1[1]) + (p1[2] + p1[3]));
                            const float rs = 1.0f / sqrtf(s * (1.0f / 512.0f) + mid_eps);
#pragma unroll
                            for (int bj = 0; bj < 2; ++bj)
#pragma unroll
                                for (int n = 0; n < 2; ++n) acc[ai][bj][m][n] = acc[ai][bj][m][n] * rs; asm volatile("" ::: "memory"); }
                    PG8_WAIT_V(0);
                    PG8_SCHED;
                }
            }
            if constexpr (SP2) {
            PG8_LDB(B0, 0, 0); PG8_LDB(B1, 0, 1); PG8_SCHED; PG8_LDA(At, 0, 0); PG8_STAGE(PG8_SA(1, 1), a1 + hstep, voffA);
            PG8_WAIT_V(8); PG8_WAIT_L(0); PG8_BAR; PG8_MMA(0, 0, At, B0); PG8_MMA(0, 1, At, B1); PG8_BAR; PG8_SCHED;
            PG8_LDA(At, 0, 1); PG8_STAGE(PG8_SB(0, 0), b2, voffB); PG8_STAGE(PG8_SB(0, 1), b2 + hstep, voffB); PG8_STAGE(PG8_SA(0, 0), a2, voffA);
            PG8_WAIT_V(8); PG8_WAIT_L(0); PG8_BAR; PG8_MMA(1, 0, At, B0); PG8_MMA(1, 1, At, B1); PG8_BAR; PG8_SCHED;
            PG8_LDB(B0, 1, 0); PG8_LDB(B1, 1, 1); PG8_SCHED; PG8_LDA(At, 1, 0); PG8_STAGE(PG8_SA(0, 1), a2 + hstep, voffA);
            PG8_WAIT_V(8); PG8_WAIT_L(0); PG8_BAR; PG8_MMA(0, 0, At, B0); PG8_MMA(0, 1, At, B1); PG8_BAR; PG8_SCHED;
            PG8_LDA(At, 1, 1); PG8_STAGE(PG8_SB(1, 0), b3, voffB); PG8_STAGE(PG8_SB(1, 1), b3 + hstep, voffB); PG8_STAGE(PG8_SA(1, 0), a3, voffA);
            PG8_WAIT_V(8); PG8_WAIT_L(0); PG8_BAR; PG8_MMA(1, 0, At, B0); PG8_MMA(1, 1, At, B1); PG8_BAR; PG8_SCHED;
            } else {
            PG8_LDB(B0, 0, 0); PG8_SCHED; PG8_LDA(At, 0, 0); PG8_STAGE(PG8_SA(1, 1), a1 + hstep, voffA);
            PG8_WAIT_L(8); PG8_BAR; PG8_WAIT_L(0); PG8_MMA(0, 0, At, B0); PG8_BAR; PG8_SCHED;
            PG8_LDB(B1, 0, 1); PG8_STAGE(PG8_SB(0, 0), b2, voffB);
            PG8_BAR; PG8_WAIT_L(0); PG8_MMA(0, 1, At, B1); PG8_BAR;
            PG8_LDA(At, 0, 1); PG8_STAGE(PG8_SA(0, 0), a2, voffA);
            PG8_BAR; PG8_WAIT_L(0); PG8_MMA(1, 0, At, B0); PG8_BAR; PG8_SCHED;
            PG8_STAGE(PG8_SB(0, 1), b2 + hstep, voffB);
            PG8_WAIT_V(6); PG8_BAR; PG8_MMA(1, 1, At, B1); PG8_BAR;
            PG8_LDB(B0, 1, 0); PG8_SCHED; PG8_LDA(At, 1, 0); PG8_STAGE(PG8_SA(0, 1), a2 + hstep, voffA);
            PG8_WAIT_L(8); PG8_BAR; PG8_WAIT_L(0); PG8_MMA(0, 0, At, B0); PG8_BAR; PG8_SCHED;
            PG8_LDB(B1, 1, 1); PG8_STAGE(PG8_SB(1, 0), b3, voffB);
            PG8_BAR; PG8_WAIT_L(0); PG8_MMA(0, 1, At, B1); PG8_BAR;
            PG8_LDA(At, 1, 1); PG8_STAGE(PG8_SA(1, 0), a3, voffA);
            PG8_BAR; PG8_WAIT_L(0); PG8_MMA(1, 0, At, B0); PG8_BAR; PG8_SCHED;
            PG8_STAGE(PG8_SB(1, 1), b3 + hstep, voffB);
            PG8_WAIT_V(6); PG8_BAR; PG8_MMA(1, 1, At, B1); PG8_BAR;
            }
        }
        if constexpr (ALIGN_EPI) { if (wr == 0) PG8_BAR; }
        E(acc, cur, wr, wc, fr, fq);
        if (!has_next) break;
#pragma unroll
        for (int a = 0; a < 2; ++a)
#pragma unroll
            for (int b = 0; b < 2; ++b)
#pragma unroll
                for (int m = 0; m < 4; ++m)
#pragma unroll
                    for (int n = 0; n < 2; ++n) acc[a][b][m][n] = (f32x4){0.f, 0.f, 0.f, 0.f};
        cur = nxt; cA = nA; cB = nB; ++ui;
        if constexpr (ALIGN_EPI) { if (wr == 1) PG8_BAR; }
    }
    PG8_WAIT_V(0);
    if constexpr (!ALIGN_EPI) { if (wr == 0) PG8_BAR; }
    PG8_BAR;
#undef PG8_SA
#undef PG8_SB
#undef PG8_STAGE
#undef PG8_LDA
#undef PG8_LDB
#undef PG8_MMA
#undef PG8_WAIT_V
#undef PG8_WAIT_L
#undef PG8_BAR
#undef PG8_SCHED
}
}

using pg8::bf16_t; using pg8::bf16x8; using pg8::f32x4; using pg8::u32x4; using pg8::u32x2; using pg8::cvt_pk_bf16;
typedef float f32x16 __attribute__((ext_vector_type(16)));
typedef short s16x4 __attribute__((ext_vector_type(4)));
constexpr int NB = 8, SEQ = 4096, DM = 1024, MTOK = NB * SEQ;
constexpr int NHEAD = 8, HD = 64, DATT = 512, DSSM = 512, NGRP = 32, GCH = 16, NST = 64, DFF = 2816;
constexpr int PROJ_LD = 1536;
constexpr int VT_LD = 32768 + 64;
constexpr float EPS = 1e-6f;
constexpr int NWAVES = 8, NTHR = 512;
constexpr int LDS_BYTES = 147456;
constexpr int MISC_OFF = 147456 - 512;

constexpr size_t MiB = 1u << 20;
constexpr size_t WS_CTL = 0, CTL_ZERO_BYTES = 65536;
constexpr int CW_BAR = 4096;
constexpr size_t WS_WIN = 1 * MiB;
constexpr size_t WS_WGLU = 5 * MiB;
constexpr size_t WS_WOUT = 6 * MiB;
constexpr size_t WS_WGU = 8 * MiB;
constexpr size_t WS_WDN = 20 * MiB;
constexpr size_t WS_SSM = 26 * MiB;
constexpr size_t WS_LAM16 = 34 * MiB;
constexpr size_t WS_PART1 = 35 * MiB;
constexpr size_t WS_PART2 = 36 * MiB;
constexpr size_t WS_PART3 = 38 * MiB;
constexpr size_t WS_XN = 48 * MiB;
constexpr size_t WS_Z = 112 * MiB;
constexpr size_t WS_VT = 176 * MiB;
constexpr size_t WS_PROJ = 210 * MiB;
constexpr size_t WS_YG = 306 * MiB;
constexpr size_t WS_H = 176 * MiB;
constexpr size_t WS_END = 352 * MiB;

__device__ __forceinline__ int crow(int r, int hi) { return (r & 3) + 8 * (r >> 2) + 4 * hi; }
__device__ __forceinline__ float2 cmul(float2 a, float2 b) { return make_float2(a.x * b.x - a.y * b.y, a.x * b.y + a.y * b.x); }
__device__ __forceinline__ unsigned short bf1(float v) { return (unsigned short)(cvt_pk_bf16(v, v) & 0xffffu); }
__device__ __forceinline__ float wave_sum(float v) {
#pragma unroll
    for (int o = 1; o < 64; o <<= 1) v += __shfl_xor(v, o);
    return v;
}

struct Args {
    const float* x; const float* norm1_g; const float* w_in; const float* attn_norm_g; const float* lambda_re; const float* lambda_im; const float* log_step;
    const float* b_re; const float* b_im; const float* c_re; const float* c_im; const float* d_skip; const float* w_glu; const float* ssm_norm_g; const float* w_out;
    const float* norm2_g; const float* w_gate; const float* w_up; const float* w_down; const float* final_norm_g;
    float* out; unsigned char* ws;
};

__device__ __forceinline__ void transpose_item(const float* W, int N, bf16_t* WT, int ldt, int k0, int n0, int drow0, int dcol0, const float* gk, float* scr, int lane) {
#pragma unroll 8
    for (int i = 0; i < 32; ++i) { const int kk = 2 * i + (lane >> 5); float v = W[(size_t)(k0 + kk) * N + n0 + (lane & 31)]; if (gk) v *= gk[k0 + kk]; scr[kk * 33 + (lane & 31)] = v; }
    asm volatile("s_waitcnt lgkmcnt(0)" ::: "memory");
    const int c = lane & 7;
#pragma unroll
    for (int j = 0; j < 4; ++j) { const int n = (lane >> 3) + 8 * j; const float* s = scr + (8 * c) * 33 + n;
        u32x4 o; o.x = cvt_pk_bf16(s[0 * 33], s[1 * 33]); o.y = cvt_pk_bf16(s[2 * 33], s[3 * 33]); o.z = cvt_pk_bf16(s[4 * 33], s[5 * 33]); o.w = cvt_pk_bf16(s[6 * 33], s[7 * 33]);
        *(u32x4*)(WT + (size_t)(drow0 + n) * ldt + dcol0 + 8 * c) = o; }
    asm volatile("s_waitcnt lgkmcnt(0)" ::: "memory");
}

__device__ __forceinline__ void ssm_mats(const Args& A, int g, char* lds) {
    float2* lamp = (float2*)lds;
    float2* bbm = lamp + 17 * 64;
    float2* cm = bbm + 1024;
    float* Kt = (float*)(cm + 1024);
    float2* fb = (float2*)(Kt + 4096);
    const int tid = threadIdx.x;
    bf16_t* WstT = (bf16_t*)(A.ws + WS_SSM + (size_t)g * 262144); bf16_t* KinT = WstT + 128 * 256; bf16_t* WinT = KinT + 256 * 256;
    if (tid < 64) { const int p = tid; const float lr = A.lambda_re[g * 64 + p], li = A.lambda_im[g * 64 + p]; const float dt = expf(A.log_step[g]);
        const float mag = expf(lr * dt), ang = li * dt; const float lbr = mag * cosf(ang), lbi = mag * sinf(ang);
        const float den = lr * lr + li * li, nr = lbr - 1.0f; fb[p] = make_float2((nr * lr + lbi * li) / den, (lbi * lr - nr * li) / den);
        float2 pw = make_float2(1.f, 0.f); const float2 lb = make_float2(lbr, lbi);
        for (int k = 0; k <= 16; ++k) { lamp[k * 64 + p] = pw; pw = cmul(pw, lb); }
        ((float2*)(A.ws + WS_LAM16))[g * 64 + p] = lamp[16 * 64 + p]; }
    __syncthreads();
    for (int idx = tid; idx < 1024; idx += NTHR) { { const int p = idx >> 4, h = idx & 15; const float br = A.b_re[(size_t)(g * 64 + p) * 16 + h], bi = A.b_im[(size_t)(g * 64 + p) * 16 + h]; const float2 f = fb[p];
            bbm[idx] = make_float2(f.x * br - f.y * bi, f.x * bi + f.y * br); }
        { const int h = idx >> 6, p = idx & 63; cm[idx] = make_float2(A.c_re[(size_t)(g * 16 + h) * 64 + p], A.c_im[(size_t)(g * 16 + h) * 64 + p]); } }
    __syncthreads();
    for (int idx = tid; idx < 4096; idx += NTHR) { const int tau = idx >> 8, h = (idx >> 4) & 15, hp = idx & 15; float s = 0.f;
        for (int p = 0; p < 64; ++p) { const float2 cl = cmul(cm[h * 64 + p], lamp[tau * 64 + p]); const float2 bq = bbm[p * 16 + hp]; s += cl.x * bq.x - cl.y * bq.y; }
        if (tau == 0 && h == hp) s += A.d_skip[g * 16 + h];
        Kt[idx] = s; }
    __syncthreads();
    for (int ch = tid; ch < 8192; ch += NTHR) { const int n = ch >> 5, kc = ch & 31, t = n >> 4, h = n & 15, s = kc >> 1, hp0 = (kc & 1) * 8; float v[8];
#pragma unroll
        for (int e = 0; e < 8; ++e) v[e] = (s <= t) ? Kt[((t - s) * 16 + h) * 16 + hp0 + e] : 0.f;
        u32x4 o; o.x = cvt_pk_bf16(v[0], v[1]); o.y = cvt_pk_bf16(v[2], v[3]); o.z = cvt_pk_bf16(v[4], v[5]); o.w = cvt_pk_bf16(v[6], v[7]);
        *(u32x4*)(KinT + (size_t)n * 256 + kc * 8) = o; }
    for (int ch = tid; ch < 4096; ch += NTHR) { const int n = ch >> 5, kc = ch & 31, nb = n >> 5, j = n & 31, p = 32 * (nb >> 1) + j, part = nb & 1, s = kc >> 1, hp0 = (kc & 1) * 8; float v[8];
        const float2 l = lamp[(15 - s) * 64 + p];
#pragma unroll
        for (int e = 0; e < 8; ++e) { const float2 w = cmul(l, bbm[p * 16 + hp0 + e]); v[e] = part ? w.y : w.x; }
        u32x4 o; o.x = cvt_pk_bf16(v[0], v[1]); o.y = cvt_pk_bf16(v[2], v[3]); o.z = cvt_pk_bf16(v[4], v[5]); o.w = cvt_pk_bf16(v[6], v[7]);
        *(u32x4*)(WstT + (size_t)n * 256 + kc * 8) = o; }
    for (int ch = tid; ch < 4096; ch += NTHR) { const int n = ch >> 4, kc = ch & 15, t = n >> 4, h = n & 15; float v[8];
#pragma unroll
        for (int e = 0; e < 8; ++e) { const int k2 = kc * 8 + e, nb2 = k2 >> 5, j2 = k2 & 31, p = 32 * (nb2 >> 1) + j2, part = nb2 & 1;
            const float2 w = cmul(cm[h * 64 + p], lamp[(t + 1) * 64 + p]); v[e] = part ? -w.y : w.x; }
        u32x4 o; o.x = cvt_pk_bf16(v[0], v[1]); o.y = cvt_pk_bf16(v[2], v[3]); o.z = cvt_pk_bf16(v[4], v[5]); o.w = cvt_pk_bf16(v[6], v[7]);
        *(u32x4*)(WinT + (size_t)n * 128 + kc * 8) = o; }
    __syncthreads();
}

__device__ __forceinline__ void p0_prologue(const Args& A, char* lds, int G) {
    const int tid = threadIdx.x, lane = tid & 63, wave = tid >> 6;
    const int bx = blockIdx.x;
    for (int g = bx; g < NGRP; g += G) ssm_mats(A, g, lds);
    float* scr = (float*)(lds + wave * 16384);
    const int gw = bx * NWAVES + wave, NGW = G * NWAVES;
    bf16_t* Win_t = (bf16_t*)(A.ws + WS_WIN); bf16_t* Wglu_t = (bf16_t*)(A.ws + WS_WGLU); bf16_t* Wout_t = (bf16_t*)(A.ws + WS_WOUT);
    bf16_t* Wgu_t = (bf16_t*)(A.ws + WS_WGU); bf16_t* Wdn_t = (bf16_t*)(A.ws + WS_WDN);
    constexpr int I_IN = 16 * 64, I_GLU = 8 * 16, I_OUT = 16 * 32, I_G = 16 * 88, I_U = 16 * 88, I_D = 44 * 32;
    constexpr int NITEMS = I_IN + I_GLU + I_OUT + I_G + I_U + I_D;
    for (int it = gw; it < NITEMS; it += NGW) {
        int r = it;
        if (r < I_IN) { const int kb = r / 64, nb = r % 64, n0 = 32 * nb; const int drow0 = (n0 < 1024) ? n0 : (n0 < 1536 ? n0 + 512 : n0 - 512);
            transpose_item(A.w_in, 2048, Win_t, 1024, 64 * kb, n0, drow0, 64 * kb, nullptr, scr, lane); continue; } r -= I_IN;
        if (r < I_GLU) { const int kb = r / 16, nb = r % 16; transpose_item(A.w_glu, 512, Wglu_t, 512, 64 * kb, 32 * nb, 32 * nb, 64 * kb, nullptr, scr, lane); continue; } r -= I_GLU;
        if (r < I_OUT) { const int kb = r / 32, nb = r % 32, k0 = 64 * kb; const bool ssm = k0 >= 512;
            transpose_item(A.w_out, 1024, Wout_t, 1024, k0, 32 * nb, 32 * nb, ssm ? k0 - 512 : k0 + 512, ssm ? (A.ssm_norm_g - 512) : A.attn_norm_g, scr, lane); continue; } r -= I_OUT;
        if (r < I_G) { const int kb = r / 88, nb = r % 88, n0 = 32 * nb; transpose_item(A.w_gate, DFF, Wgu_t, 1024, 64 * kb, n0, 256 * (n0 / 128) + (n0 % 128), 64 * kb, A.norm2_g, scr, lane); continue; } r -= I_G;
        if (r < I_U) { const int kb = r / 88, nb = r % 88, n0 = 32 * nb; transpose_item(A.w_up, DFF, Wgu_t, 1024, 64 * kb, n0, 256 * (n0 / 128) + 128 + (n0 % 128), 64 * kb, A.norm2_g, scr, lane); continue; } r -= I_U;
        { const int kb = r / 32, nb = r % 32; transpose_item(A.w_down, 1024, Wdn_t, DFF, 64 * kb, 32 * nb, 32 * nb, 64 * kb, nullptr, scr, lane); }
    }
    bf16_t* XN = (bf16_t*)(A.ws + WS_XN);
    f32x4 gv[4];
#pragma unroll
    for (int j = 0; j < 4; ++j) gv[j] = ((const f32x4*)A.norm1_g)[lane + 64 * j];
    const int nskip = (G > 2 * NGRP) ? NGRP : 0;
    if (bx >= nskip) {
        const int gw2 = (bx - nskip) * NWAVES + wave, NGW2 = (G - nskip) * NWAVES;
        for (int m = gw2; m < MTOK; m += 2 * NGW2) {
            const int m1 = m + NGW2; const bool has1 = m1 < MTOK;
            const f32x4* xr0 = (const f32x4*)(A.x + (size_t)m * DM) + lane; const f32x4* xr1 = (const f32x4*)(A.x + (size_t)(has1 ? m1 : m) * DM) + lane;
            f32x4 v0[4], v1[4]; float s0 = 0.f, s1 = 0.f;
#pragma unroll
            for (int j = 0; j < 4; ++j) { v0[j] = xr0[64 * j]; v1[j] = xr1[64 * j]; }
#pragma unroll
            for (int j = 0; j < 4; ++j) { s0 += (v0[j][0] * v0[j][0] + v0[j][1] * v0[j][1]) + (v0[j][2] * v0[j][2] + v0[j][3] * v0[j][3]); s1 += (v1[j][0] * v1[j][0] + v1[j][1] * v1[j][1]) + (v1[j][2] * v1[j][2] + v1[j][3] * v1[j][3]); }
            const float rs0 = 1.0f / sqrtf(wave_sum(s0) * (1.0f / DM) + EPS), rs1 = 1.0f / sqrtf(wave_sum(s1) * (1.0f / DM) + EPS);
            u32x2* o0 = (u32x2*)(XN + (size_t)m * DM) + lane;
#pragma unroll
            for (int j = 0; j < 4; ++j) { u32x2 w; w.x = cvt_pk_bf16(v0[j][0] * rs0 * gv[j][0], v0[j][1] * rs0 * gv[j][1]); w.y = cvt_pk_bf16(v0[j][2] * rs0 * gv[j][2], v0[j][3] * rs0 * gv[j][3]); o0[64 * j] = w; }
            if (has1) { u32x2* o1 = (u32x2*)(XN + (size_t)m1 * DM) + lane;
#pragma unroll
                for (int j = 0; j < 4; ++j) { u32x2 w; w.x = cvt_pk_bf16(v1[j][0] * rs1 * gv[j][0], v1[j][1] * rs1 * gv[j][1]); w.y = cvt_pk_bf16(v1[j][2] * rs1 * gv[j][2], v1[j][3] * rs1 * gv[j][3]); o1[64 * j] = w; } }
        }
    }
}

__device__ __forceinline__ float gelu_tanh(float y) {
    const float u = 0.7978845608028654f * (y + 0.044715f * y * y * y);
    return y * __builtin_amdgcn_rcpf(1.0f + __builtin_amdgcn_exp2f(-2.0f * 1.4426950408889634f * u));
}
template <int NCHUNK_PER_THREAD, int ROWB, int DSTRIDE>
__device__ __forceinline__ void lds_fill(char* dst, const bf16_t* src, int tid) {
    u32x4 v[NCHUNK_PER_THREAD];
#pragma unroll
    for (int i = 0; i < NCHUNK_PER_THREAD; ++i) v[i] = ((const u32x4*)src)[tid + i * NTHR];
#pragma unroll
    for (int i = 0; i < NCHUNK_PER_THREAD; ++i) { const int c = tid + i * NTHR, row = c / (ROWB / 16), col = c % (ROWB / 16); *(u32x4*)(dst + row * DSTRIDE + col * 16) = v[i]; }
}
__device__ __forceinline__ void ssm_item(const Args& A, int b, int g, char* lds) {
    const int tid = threadIdx.x, lane = tid & 63, w = __builtin_amdgcn_readfirstlane(tid >> 6), j = lane & 31, hi = lane >> 5;
    char* R2 = lds;
    float2* E = (float2*)lds;
    bf16_t* XS = (bf16_t*)(lds + 65536);
    float2* SEG = (float2*)(lds + 65536 + 69632);
    const bf16_t* PROJ = (const bf16_t*)(A.ws + WS_PROJ);
    const bf16_t* WstT = (const bf16_t*)(A.ws + WS_SSM + (size_t)g * 262144); const bf16_t* KinT = WstT + 128 * 256; const bf16_t* WinT = KinT + 256 * 256;
    const float2* LAM16 = (const float2*)(A.ws + WS_LAM16);
    bf16_t* YG = (bf16_t*)(A.ws + WS_YG);
    bf16x8 ua[16];
    { const bf16_t* up = PROJ + ((size_t)(b * SEQ + 16 * (32 * w + j))) * PROJ_LD + 1024 + g * 16 + 8 * hi;
#pragma unroll
      for (int tl = 0; tl < 16; ++tl) ua[tl] = *(const bf16x8*)(up + (size_t)tl * PROJ_LD); }
#pragma unroll 1
    for (int hp = 0; hp < 2; ++hp) {
        lds_fill<4, 512, 528>(R2, WstT + (size_t)64 * hp * 256, tid);
        __syncthreads();
        f32x16 are = {}, aim = {};
        const char* bl = R2 + j * 528 + hi * 16;
#pragma unroll
        for (int ks = 0; ks < 16; ++ks) { const bf16x8 br = *(const bf16x8*)(bl + ks * 32), bi = *(const bf16x8*)(bl + 32 * 528 + ks * 32);
            are = __builtin_amdgcn_mfma_f32_32x32x16_bf16(ua[ks], br, are, 0, 0, 0); aim = __builtin_amdgcn_mfma_f32_32x32x16_bf16(ua[ks], bi, aim, 0, 0, 0); }
        __syncthreads();
#pragma unroll
        for (int r = 0; r < 16; ++r) E[(32 * w + crow(r, hi)) * 32 + j] = make_float2(are[r], aim[r]);
        __syncthreads();
        { const int seg = tid >> 5, pl = tid & 31; const float2 l16 = LAM16[g * 64 + 32 * hp + pl];
          float2 x = make_float2(0.f, 0.f);
#pragma unroll
          for (int i = 0; i < 16; ++i) { const float2 e = E[(16 * seg + i) * 32 + pl]; const float2 t = cmul(l16, x); x = make_float2(t.x + e.x, t.y + e.y); }
          SEG[seg * 32 + pl] = x;
          __syncthreads();
          float2 l256 = l16;
#pragma unroll
          for (int q = 0; q < 4; ++q) l256 = cmul(l256, l256);
          float2 xs = make_float2(0.f, 0.f);
          for (int s2 = 0; s2 < seg; ++s2) { const float2 e = SEG[s2 * 32 + pl]; const float2 t = cmul(l256, xs); xs = make_float2(t.x + e.x, t.y + e.y); }
          x = xs;
#pragma unroll
          for (int i = 0; i < 16; ++i) { const int c = 16 * seg + i; XS[c * 136 + 64 * hp + pl] = bf1(x.x); XS[c * 136 + 64 * hp + 32 + pl] = bf1(x.y);
              const float2 e = E[c * 32 + pl]; const float2 t = cmul(l16, x); x = make_float2(t.x + e.x, t.y + e.y); } }
        __syncthreads();
    }
#pragma unroll 1
    for (int qd = 0; qd < 4; ++qd) {
        lds_fill<4, 512, 528>(R2, KinT + (size_t)64 * qd * 256, tid);
        lds_fill<2, 256, 272>(R2 + 33792, WinT + (size_t)64 * qd * 128, tid);
        __syncthreads();
        f32x16 acc[2]; acc[0] = f32x16{}; acc[1] = f32x16{};
        const char* kl = R2 + j * 528 + hi * 16;
#pragma unroll
        for (int ks = 0; ks < 16; ++ks)
#pragma unroll
            for (int q = 0; q < 2; ++q) { if (ks <= 2 * (2 * qd + q) + 1) {
                    const bf16x8 bv = *(const bf16x8*)(kl + q * 32 * 528 + ks * 32); acc[q] = __builtin_amdgcn_mfma_f32_32x32x16_bf16(ua[ks], bv, acc[q], 0, 0, 0); } }
        const char* wl = R2 + 33792 + j * 272 + hi * 16;
#pragma unroll
        for (int k2 = 0; k2 < 8; ++k2) { const bf16x8 av = *(const bf16x8*)(XS + (32 * w + j) * 136 + 16 * k2 + 8 * hi);
#pragma unroll
            for (int q = 0; q < 2; ++q) { const bf16x8 bv = *(const bf16x8*)(wl + q * 32 * 272 + k2 * 32); acc[q] = __builtin_amdgcn_mfma_f32_32x32x16_bf16(av, bv, acc[q], 0, 0, 0); } }
#pragma unroll
        for (int q = 0; q < 2; ++q) { const int n = 64 * qd + 32 * q + j, t = n >> 4, h = n & 15;
#pragma unroll
            for (int r = 0; r < 16; ++r) { const int c = 32 * w + crow(r, hi); const int tok = 16 * c + t;
                YG[(size_t)(b * SEQ + tok) * DSSM + g * 16 + h] = bf1(gelu_tanh(acc[q][r])); } }
        __syncthreads();
    }
}

constexpr float ATT_SC = 0.125f * 1.4426950408889634f;
constexpr float ATT_STOP = 160.0f;
struct KVTile { bf16x8 kf[4]; s16x4 va[2][2], vb[2][2]; };
__device__ __forceinline__ void kv_load(KVTile& t, const bf16_t* kbase, const bf16_t* vbase, int kt, int j) {
    const int k0 = 32 * kt; const bf16_t* kp = kbase + (size_t)(k0 + j) * PROJ_LD;
#pragma unroll
    for (int d0 = 0; d0 < 4; ++d0) t.kf[d0] = *(const bf16x8*)(kp + 16 * d0);
#pragma unroll
    for (int db = 0; db < 2; ++db)
#pragma unroll
        for (int ks = 0; ks < 2; ++ks) { const bf16_t* vp = vbase + (size_t)db * 32 * VT_LD + k0 + 16 * ks; t.va[db][ks] = *(const s16x4*)(vp); t.vb[db][ks] = *(const s16x4*)(vp + 8); }
}
__device__ __forceinline__ void attn_tile(const KVTile& t, const bf16x8 (&qf)[4], f32x16& o0, f32x16& o1, float& R2, bool diag, int j, int hi) {
    f32x16 s = {};
#pragma unroll
    for (int d0 = 0; d0 < 4; ++d0) s = __builtin_amdgcn_mfma_f32_32x32x16_bf16(t.kf[d0], qf[d0], s, 0, 0, 0);
    float L[16], z2[16];
#pragma unroll
    for (int r = 0; r < 16; ++r) { const float z = s[r] * ATT_SC; const float e = __builtin_amdgcn_exp2f(-fabsf(z));
        const float l = fmaxf(z, 0.f) + __builtin_amdgcn_logf(1.0f + e);
        const bool msk = diag && (crow(r, hi) >= j); L[r] = msk ? 0.f : l; z2[r] = msk ? -1e30f : z; }
    float gs[4], pg[4];
#pragma unroll
    for (int g4 = 0; g4 < 4; ++g4) { gs[g4] = (L[4 * g4] + L[4 * g4 + 1]) + (L[4 * g4 + 2] + L[4 * g4 + 3]); pg[g4] = __shfl_xor(gs[g4], 32); }
    float T[4]; T[3] = 0.f; T[2] = gs[3] + pg[3]; T[1] = T[2] + (gs[2] + pg[2]); T[0] = T[1] + (gs[1] + pg[1]);
    const float total = T[0] + (gs[0] + pg[0]);
    float wv[16];
#pragma unroll
    for (int g4 = 0; g4 < 4; ++g4) { const float after = T[g4] + (hi == 0 ? pg[g4] : 0.f) + R2;
        const float s3 = after, s2 = s3 + L[4 * g4 + 3], s1 = s2 + L[4 * g4 + 2], s0 = s1 + L[4 * g4 + 1];
        wv[4 * g4 + 3] = __builtin_amdgcn_exp2f(z2[4 * g4 + 3] - L[4 * g4 + 3] - s3);
        wv[4 * g4 + 2] = __builtin_amdgcn_exp2f(z2[4 * g4 + 2] - L[4 * g4 + 2] - s2);
        wv[4 * g4 + 1] = __builtin_amdgcn_exp2f(z2[4 * g4 + 1] - L[4 * g4 + 1] - s1);
        wv[4 * g4 + 0] = __builtin_amdgcn_exp2f(z2[4 * g4 + 0] - L[4 * g4 + 0] - s0); }
    R2 += total;
    u32x4 p0, p1;
    p0.x = cvt_pk_bf16(wv[0], wv[1]); p0.y = cvt_pk_bf16(wv[2], wv[3]); p0.z = cvt_pk_bf16(wv[4], wv[5]); p0.w = cvt_pk_bf16(wv[6], wv[7]);
    p1.x = cvt_pk_bf16(wv[8], wv[9]); p1.y = cvt_pk_bf16(wv[10], wv[11]); p1.z = cvt_pk_bf16(wv[12], wv[13]); p1.w = cvt_pk_bf16(wv[14], wv[15]);
    const bf16x8 pa0 = __builtin_bit_cast(bf16x8, p0), pa1 = __builtin_bit_cast(bf16x8, p1);
    bf16x8 vf[2][2];
#pragma unroll
    for (int db = 0; db < 2; ++db)
#pragma unroll
        for (int ks = 0; ks < 2; ++ks) vf[db][ks] = (bf16x8){t.va[db][ks][0], t.va[db][ks][1], t.va[db][ks][2], t.va[db][ks][3], t.vb[db][ks][0], t.vb[db][ks][1], t.vb[db][ks][2], t.vb[db][ks][3]};
    o0 = __builtin_amdgcn_mfma_f32_32x32x16_bf16(pa0, vf[0][0], o0, 0, 0, 0); o0 = __builtin_amdgcn_mfma_f32_32x32x16_bf16(pa1, vf[0][1], o0, 0, 0, 0);
    o1 = __builtin_amdgcn_mfma_f32_32x32x16_bf16(pa0, vf[1][0], o1, 0, 0, 0); o1 = __builtin_amdgcn_mfma_f32_32x32x16_bf16(pa1, vf[1][1], o1, 0, 0, 0);
}
__device__ __forceinline__ void attn_item(const Args& A, int b, int qt, char* lds) {
    const int tid = threadIdx.x, lane = tid & 63, h = __builtin_amdgcn_readfirstlane(tid >> 6), j = lane & 31, hi = lane >> 5;
    float* OST = (float*)lds + h * (32 * 68);
    float* PART = (float*)(lds + 69632);
    const bf16_t* PROJ = (const bf16_t*)(A.ws + WS_PROJ);
    const bf16_t* VT = (const bf16_t*)(A.ws + WS_VT);
    bf16_t* Z = (bf16_t*)(A.ws + WS_Z);
    const int q0 = 32 * qt; const size_t rowbase = (size_t)b * SEQ;
    const bf16_t* kbase = PROJ + rowbase * PROJ_LD + 512 + h * 64 + 8 * hi;
    const bf16_t* vbase = VT + (size_t)(h * 64 + j) * VT_LD + rowbase + 4 * hi;
    KVTile t0, t1, t2;
    kv_load(t0, kbase, vbase, qt, j);
    bf16x8 qf[4];
    { const bf16_t* qp = PROJ + (rowbase + q0 + j) * PROJ_LD + h * 64 + 8 * hi;
#pragma unroll
      for (int d0 = 0; d0 < 4; ++d0) qf[d0] = *(const bf16x8*)(qp + 16 * d0); }
    kv_load(t1, kbase, vbase, qt > 1 ? qt - 1 : 0, j);
    kv_load(t2, kbase, vbase, qt > 2 ? qt - 2 : 0, j);
    f32x16 o0 = {}, o1 = {}; float R2 = 0.f;
    for (int kt = qt;;) {
        attn_tile(t0, qf, o0, o1, R2, kt == qt, j, hi); if (kt == 0 || __all(R2 > ATT_STOP)) break; kv_load(t0, kbase, vbase, kt > 3 ? kt - 3 : 0, j); --kt;
        attn_tile(t1, qf, o0, o1, R2, false, j, hi);    if (kt == 0 || __all(R2 > ATT_STOP)) break; kv_load(t1, kbase, vbase, kt > 3 ? kt - 3 : 0, j); --kt;
        attn_tile(t2, qf, o0, o1, R2, false, j, hi);    if (kt == 0 || __all(R2 > ATT_STOP)) break; kv_load(t2, kbase, vbase, kt > 3 ? kt - 3 : 0, j); --kt;
    }
#pragma unroll
    for (int r = 0; r < 16; ++r) { OST[crow(r, hi) * 68 + j] = o0[r]; OST[crow(r, hi) * 68 + 32 + j] = o1[r]; }
    asm volatile("s_waitcnt lgkmcnt(0)" ::: "memory");
    f32x4 ov[8]; float ss = 0.f;
#pragma unroll
    for (int e = 0; e < 8; ++e) { ov[e] = *(const f32x4*)(OST + j * 68 + 32 * hi + 4 * e); ss += (ov[e][0] * ov[e][0] + ov[e][1] * ov[e][1]) + (ov[e][2] * ov[e][2] + ov[e][3] * ov[e][3]); }
    PART[(h * 32 + j) * 2 + hi] = ss;
    __syncthreads();
    float tot = 0.f;
#pragma unroll
    for (int w2 = 0; w2 < 8; ++w2) { tot += PART[(w2 * 32 + j) * 2] + PART[(w2 * 32 + j) * 2 + 1]; }
    const float rs = 1.0f / sqrtf(tot * (1.0f / DATT) + EPS);
    bf16_t* zp = Z + (rowbase + q0 + j) * 1024 + 512 + h * 64 + 32 * hi;
#pragma unroll
    for (int e = 0; e < 4; ++e) { const f32x4 a = ov[2 * e] * rs, c = ov[2 * e + 1] * rs; u32x4 w;
        w.x = cvt_pk_bf16(a[0], a[1]); w.y = cvt_pk_bf16(a[2], a[3]); w.z = cvt_pk_bf16(c[0], c[1]); w.w = cvt_pk_bf16(c[2], c[3]); *(u32x4*)(zp + 8 * e) = w; }
    __syncthreads();
}


#define LAS __attribute__((address_space(3)))
#define XB_TMO      128
#define XB_XCNT(j)  (256  + 64 * (j))
#define XB_XSUB(j)  (1280 + 64 * (j))
#define XB_XGEN(j)  (2304 + 64 * (j))
#define XB_TOP      3328
#define XB_TOPGEN   3392
#define XCD_BAR_WORDS 3456
#define XB_SPIN_CAP (1u << 18)
__device__ __forceinline__ unsigned xb_ld(unsigned* p)              { return __hip_atomic_load(p, __ATOMIC_RELAXED, __HIP_MEMORY_SCOPE_AGENT); }
__device__ __forceinline__ unsigned xb_add(unsigned* p, unsigned v) { return __hip_atomic_fetch_add(p, v, __ATOMIC_RELAXED, __HIP_MEMORY_SCOPE_AGENT); }
__device__ __forceinline__ unsigned xb_xcc_id() { return (unsigned)__builtin_amdgcn_s_getreg((3 << 11) | 20) & 0xFu; }
#define XB_SPIN(cond, bar) do { unsigned _sp = 0; while (cond) { __builtin_amdgcn_s_sleep(1); \
    if ((++_sp & 255u) == 0u) { if (xb_ld(&(bar)[XB_TMO])) break; if (_sp > XB_SPIN_CAP) { atomicAdd(&(bar)[XB_TMO], 1u); break; } } } } while (0)
struct XcdBarrier { unsigned* bar; unsigned x; volatile LAS unsigned* st; };
__device__ __forceinline__ XcdBarrier xcd_barrier_post(unsigned* bar, volatile LAS unsigned* st) {
    XcdBarrier b; b.bar = bar; b.x = xb_xcc_id(); b.st = st;
    if (threadIdx.x == 0) (void)xb_add(&bar[XB_XCNT(b.x)], 1u);
    return b;
}
__device__ __forceinline__ void xcd_barrier_complete(unsigned* bar, unsigned x, unsigned& nloc, unsigned& nx) {
    const unsigned G = gridDim.x * gridDim.y * gridDim.z;
    unsigned sum, cnt, mine, sp = 0u;
    for (;;) {
        sum = 0u; cnt = 0u; mine = 0u;
#pragma unroll
        for (unsigned j = 0; j < 16; ++j) { const unsigned c = xb_ld(&bar[XB_XCNT(j)]); sum += c; cnt += (c > 0u) ? 1u : 0u; mine = (j == x) ? c : mine; }
        if (sum == G) break;
        __builtin_amdgcn_s_sleep(1);
        if ((++sp & 255u) == 0u) { if (xb_ld(&bar[XB_TMO])) break; if (sp > XB_SPIN_CAP) { atomicAdd(&bar[XB_TMO], 1u); break; } }
    }
    nloc = mine > 0u ? mine : 1u; nx = cnt > 0u ? cnt : 1u;
}
__device__ __forceinline__ void xcd_barrier(const XcdBarrier& b) {
    asm volatile("s_waitcnt vmcnt(0)" ::: "memory");
    __syncthreads();
    if (threadIdx.x == 0) {
        unsigned* bar = b.bar;
        __builtin_amdgcn_s_waitcnt(0);
        unsigned nloc = b.st[0], nx = b.st[1];
        if (nloc == 0u) { xcd_barrier_complete(bar, b.x, nloc, nx); b.st[0] = nloc; b.st[1] = nx; }
        const unsigned old = xb_add(&bar[XB_XSUB(b.x)], 1u);
        const unsigned gen = old / nloc;
        if (old + 1u == (gen + 1u) * nloc) {
            __builtin_amdgcn_fence(__ATOMIC_RELEASE, "agent");
            asm volatile("s_waitcnt vmcnt(0)" ::: "memory");
            const unsigned og = xb_add(&bar[XB_TOP], 1u);
            const unsigned tg = og / nx;
            if (og + 1u == (tg + 1u) * nx) xb_add(&bar[XB_TOPGEN], 1u);
            else XB_SPIN(xb_ld(&bar[XB_TOPGEN]) == tg, bar);
            __builtin_amdgcn_fence(__ATOMIC_ACQUIRE, "agent");
            xb_add(&bar[XB_XGEN(b.x)], 1u);
            asm volatile("s_waitcnt vmcnt(0)" ::: "memory");
        } else {
            XB_SPIN(xb_ld(&bar[XB_XGEN(b.x)]) == gen, bar);
            __builtin_amdgcn_fence(__ATOMIC_ACQUIRE, "agent");
            asm volatile("s_waitcnt vmcnt(0)" ::: "memory");
        }
    }
    __syncthreads();
}

__global__ void __launch_bounds__(NTHR, 2) hymba_fwd(Args A) {
    extern __shared__ __attribute__((aligned(16))) unsigned char lds[];
    cg::grid_group grid = cg::this_grid();
    const int G = gridDim.x, bx = blockIdx.x;
    PG8_LAS unsigned char* lds3 = (PG8_LAS unsigned char*)lds;
    volatile LAS unsigned* MISC = (volatile LAS unsigned*)(lds3 + MISC_OFF);
    if (threadIdx.x < 32) MISC[threadIdx.x] = 0u;
    __syncthreads();
    XcdBarrier bar = xcd_barrier_post((unsigned*)(A.ws + WS_CTL) + CW_BAR, MISC + 8);
#ifdef PROBE_A
    volatile LAS unsigned long long* STAMP = (volatile LAS unsigned long long*)(lds3 + MISC_OFF + 128);
#define STAMPIT(i) do { if (threadIdx.x == 0) STAMP[i] = __builtin_amdgcn_s_memrealtime(); } while (0)
#ifndef PROBE_BX
#define PROBE_BX 0
#endif
#else
#define STAMPIT(i) do {} while (0)
#endif
    STAMPIT(0);

#ifndef NO_P0
    p0_prologue(A, (char*)lds, G);
#endif
    if (A.ws == nullptr) grid.sync();
    xcd_barrier(bar);
    STAMPIT(1);

#ifndef NO_P1
    {
        pg8::Gemm g{(const bf16_t*)(A.ws + WS_XN), (const bf16_t*)(A.ws + WS_WIN), MTOK, 1536, DM}; pg8::StaticOrder S; S.init(MTOK, 1536, G, bx);
        pg8::EpiStore E{(bf16_t*)(A.ws + WS_PROJ), PROJ_LD};
        pg8::gemm_phase<pg8::EpiStore, pg8::StaticOrder, true, true, false>(lds3, g, S, E, nullptr, 0.f);
        pg8::Gemm g2{(const bf16_t*)(A.ws + WS_WIN) + (size_t)1536 * DM, (const bf16_t*)(A.ws + WS_XN), 512, MTOK, DM}; pg8::StaticOrder S2; S2.init(512, MTOK, G, bx);
        pg8::EpiStore E2{(bf16_t*)(A.ws + WS_VT), VT_LD};
        pg8::gemm_phase<pg8::EpiStore, pg8::StaticOrder, true, true, false>(lds3, g2, S2, E2, nullptr, 0.f);
    }
#endif
    xcd_barrier(bar);
    STAMPIT(2);

#ifndef NO_SSM
    for (int it = bx; it < NB * NGRP; it += G) ssm_item(A, it >> 5, it & 31, (char*)lds);
#endif
    STAMPIT(9);
#ifndef NO_ATT
    for (int it = bx; it < NB * (SEQ / 32); it += G) attn_item(A, it >> 7, it & 127, (char*)lds);
#endif
    STAMPIT(10);
    xcd_barrier(bar);
    STAMPIT(3);

#ifndef NO_P3
    {
        pg8::Gemm g{(const bf16_t*)(A.ws + WS_YG), (const bf16_t*)(A.ws + WS_WGLU), MTOK, 512, 512}; pg8::StaticOrder S; S.init(MTOK, 512, G, bx);
        pg8::EpiGlu E{(const bf16_t*)(A.ws + WS_YG), (bf16_t*)(A.ws + WS_Z), (float*)(A.ws + WS_PART1)};
        pg8::gemm_phase<pg8::EpiGlu, pg8::StaticOrder, true, true, false>(lds3, g, S, E, nullptr, 0.f);
    }
#endif
    xcd_barrier(bar);
    STAMPIT(4);

#ifndef NO_P4
    {
        pg8::Gemm g{(const bf16_t*)(A.ws + WS_Z), (const bf16_t*)(A.ws + WS_WOUT), MTOK, DM, DM}; pg8::StaticOrder S; S.init(MTOK, DM, G, bx);
        pg8::EpiRes E{A.x, A.out, (bf16_t*)(A.ws + WS_XN), (float*)(A.ws + WS_PART2)};
        pg8::gemm_phase<pg8::EpiRes, pg8::StaticOrder, true, true, true>(lds3, g, S, E, (const float*)(A.ws + WS_PART1), EPS);
    }
#endif
    xcd_barrier(bar);
    STAMPIT(5);

#ifndef NO_P5
    {
        pg8::Gemm g{(const bf16_t*)(A.ws + WS_XN), (const bf16_t*)(A.ws + WS_WGU), MTOK, 2 * DFF, DM}; pg8::StaticOrder S; S.init(MTOK, 2 * DFF, G, bx);
        pg8::EpiGateUp E{(bf16_t*)(A.ws + WS_H), (const float*)(A.ws + WS_PART2), EPS};
        pg8::gemm_phase<pg8::EpiGateUp, pg8::StaticOrder, true, true, false>(lds3, g, S, E, nullptr, 0.f);
    }
#endif
    xcd_barrier(bar);
    STAMPIT(6);

#ifndef NO_P6
    {
        pg8::Gemm g{(const bf16_t*)(A.ws + WS_H), (const bf16_t*)(A.ws + WS_WDN), MTOK, DM, DFF}; pg8::StaticOrder S; S.init(MTOK, DM, G, bx);
        pg8::EpiRes E{A.out, A.out, nullptr, (float*)(A.ws + WS_PART3)};
        pg8::gemm_phase<pg8::EpiRes, pg8::StaticOrder, true, true, false>(lds3, g, S, E, nullptr, 0.f);
    }
#endif
    xcd_barrier(bar);
    STAMPIT(7);

    {
        int tid7 = threadIdx.x; asm volatile("" : "+v"(tid7));
        const int wave = tid7 >> 6, lane = tid7 & 63;
        const int gw = bx * NWAVES + wave, NGW = G * NWAVES;
        f32x4 gv[4];
#pragma unroll
        for (int j = 0; j < 4; ++j) gv[j] = ((const f32x4*)A.final_norm_g)[lane + 64 * j];
        const float* part = (const float*)(A.ws + WS_PART3);
        for (int m = gw; m < MTOK; m += NGW) {
            const f32x4* pp = (const f32x4*)(part + (size_t)m * 16); const f32x4 p0 = pp[0], p1 = pp[1], p2 = pp[2], p3 = pp[3];
            const float s = ((p0[0] + p0[1]) + (p0[2] + p0[3])) + ((p1[0] + p1[1]) + (p1[2] + p1[3])) + ((p2[0] + p2[1]) + (p2[2] + p2[3])) + ((p3[0] + p3[1]) + (p3[2] + p3[3]));
            const float rs = 1.0f / sqrtf(s * (1.0f / DM) + EPS);
            f32x4* xr = (f32x4*)(A.out + (size_t)m * DM) + lane;
#pragma unroll
            for (int j = 0; j < 4; ++j) { const f32x4 v = xr[64 * j]; xr[64 * j] = v * rs * gv[j]; }
        }
    }
#ifdef PROBE_A
    STAMPIT(8);
    if (bx == PROBE_BX && threadIdx.x == 0) { const unsigned long long dt = STAMP[PROBE_B] - STAMP[PROBE_A]; const unsigned long long t0 = __builtin_amdgcn_s_memrealtime(); while (__builtin_amdgcn_s_memrealtime() - t0 < dt) __builtin_amdgcn_s_sleep(8); }
#endif
}

extern "C" void kernel_launch(void* const* d_in, const int* in_sizes, int n_in, void* d_out, int out_size, void* d_ws, size_t ws_size, hipStream_t stream) {
    static int grid = 0;
    if (grid == 0) {
        if (n_in != 20 || in_sizes[0] != MTOK * DM || out_size != MTOK * DM || ws_size < WS_END) { fprintf(stderr, "kernel_launch: unexpected problem shape / workspace (%d inputs, ws %zu)\n", n_in, ws_size); grid = -1; return; }
        int dev = 0, cus = 0, per_cu = 0;
        if (hipGetDevice(&dev) != hipSuccess || hipDeviceGetAttribute(&cus, hipDeviceAttributeMultiprocessorCount, dev) != hipSuccess) { grid = -1; return; }
        if (hipFuncSetAttribute((const void*)hymba_fwd, hipFuncAttributeMaxDynamicSharedMemorySize, LDS_BYTES) != hipSuccess) { fprintf(stderr, "kernel_launch: hipFuncSetAttribute failed\n"); grid = -1; return; }
        if (hipOccupancyMaxActiveBlocksPerMultiprocessor(&per_cu, (const void*)hymba_fwd, NTHR, LDS_BYTES) != hipSuccess || per_cu < 1) { fprintf(stderr, "kernel_launch: occupancy query says %d\n", per_cu); per_cu = 1; }
        (void)hipGetLastError();
        grid = cus * 1;
    }
    if (grid < 0) return;
    if (hipMemsetAsync((char*)d_ws + WS_CTL, 0, CTL_ZERO_BYTES, stream) != hipSuccess) { fprintf(stderr, "kernel_launch: memset failed\n"); return; }
    Args a{};
    const float** f = (const float**)&a;
    for (int i = 0; i < 20; ++i) f[i] = (const float*)d_in[i];
    a.out = (float*)d_out; a.ws = (unsigned char*)d_ws;
    void* args[] = {&a};
    hipError_t e = hipLaunchCooperativeKernel((const void*)hymba_fwd, dim3(grid), dim3(NTHR), args, LDS_BYTES, stream);
    if (e != hipSuccess) fprintf(stderr, "cooperative launch failed: %s (grid %d)\n", hipGetErrorString(e), grid);
}
```

```cpp
#include <hip/hip_runtime.h>
#include <hip/hip_cooperative_groups.h>
#include <cstdio>
#include <cstdint>
namespace cg = cooperative_groups;

namespace pg8 {
#define PG8_LAS __attribute__((address_space(3)))
typedef unsigned short bf16_t;
typedef short bf16x8 __attribute__((ext_vector_type(8)));
typedef float f32x4 __attribute__((ext_vector_type(4)));
typedef float f32x2 __attribute__((ext_vector_type(2)));
typedef unsigned u32x4 __attribute__((ext_vector_type(4)));
typedef unsigned u32x2 __attribute__((ext_vector_type(2)));
constexpr int BM = 256, BK = 64, HALF = 128, HTB = HALF * BK * 2, STAGE_BYTES = 8 * HTB, NXCD = 8, WGM = 8;

__host__ __device__ __forceinline__ int lds_byte(int r, int c) { const int st = (r >> 4) * 2 + (c >> 5), rr = r & 15, cc = c & 31, ob = rr * 64 + cc * 2; return st * 1024 + (ob ^ (((ob >> 9) & 1) << 5)); }
__host__ __device__ __forceinline__ void stage_rc(int b, int& R, int& C) { const int st = b / 1024, sb = b % 1024, swz = sb ^ (((sb >> 9) & 1) << 5); R = (st >> 1) * 16 + swz / 64; C = (st & 1) * 32 + (swz % 64) / 2; }
__host__ __device__ __forceinline__ int perm32(int rho) { const int n = rho >> 4, i = rho & 15; return 8 * (i >> 2) + 4 * n + (i & 3); }

struct Unit { int pm, pn; };
struct Gemm { const bf16_t* A; const bf16_t* Bt; int M, N, K; };

struct StaticOrder {
    int nM, nN, nwg, G, c;
    __host__ __device__ void init(int M, int N, int G_, int c_) { nM = M / BM; nN = N / BM; nwg = nM * nN; G = G_; c = c_; }
    __host__ __device__ bool next(int i, Unit& u) const {
        const long L = (long)i * G + c; if (L >= nwg) return false;
        int wgid = (int)L; { const int q = nwg / NXCD, r = nwg % NXCD, xcd = wgid % NXCD, off = wgid / NXCD; wgid = (xcd < r ? xcd * (q + 1) : r * (q + 1) + (xcd - r) * q) + off; }
        const int nig = WGM * nN, gid = wgid / nig, fm = gid * WGM, gsz = (nM - fm) < WGM ? (nM - fm) : WGM;
        u.pm = fm + ((wgid % nig) % gsz); u.pn = (wgid % nig) / gsz; return true;
    }
    __device__ __forceinline__ void a_ready(const Unit&) const {}
    __device__ __forceinline__ void done(const Unit&) const {}
};

__device__ __forceinline__ unsigned cvt_pk_bf16(float lo, float hi) { unsigned r; asm volatile("v_cvt_pk_bf16_f32 %0, %1, %2" : "=v"(r) : "v"(lo), "v"(hi)); return r; }
__device__ __forceinline__ float bf_lo(unsigned w) { return __uint_as_float(w << 16); }
__device__ __forceinline__ float bf_hi(unsigned w) { return __uint_as_float(w & 0xffff0000u); }

struct EpiStore {
    static constexpr bool PERM = true;
    bf16_t* O; int ldc;
    __device__ __forceinline__ void operator()(const f32x4 (&acc)[2][2][4][2], const Unit& u, int wr, int wc, int fr, int fq) const {
        asm volatile("" : "+v"(fr), "+v"(fq));
        const int row0 = u.pm * BM + wr * 64 + fr, col0 = u.pn * BM + wc * 32 + 8 * fq;
#pragma unroll
        for (int ai = 0; ai < 2; ++ai)
#pragma unroll
            for (int m = 0; m < 4; ++m) { bf16_t* rowp = O + (size_t)(row0 + ai * HALF + m * 16) * ldc + col0;
#pragma unroll
                for (int bj = 0; bj < 2; ++bj) { const f32x4 v0 = acc[ai][bj][m][0], v1 = acc[ai][bj][m][1];
                    u32x4 w; w.x = cvt_pk_bf16(v0[0], v0[1]); w.y = cvt_pk_bf16(v0[2], v0[3]); w.z = cvt_pk_bf16(v1[0], v1[1]); w.w = cvt_pk_bf16(v1[2], v1[3]);
                    *(u32x4*)(rowp + bj * HALF) = w; } }
    }
};
__device__ __forceinline__ float sigmoidf_fast(float a) { return __builtin_amdgcn_rcpf(1.0f + __builtin_amdgcn_exp2f(-1.4426950408889634f * a)); }
struct EpiGlu {
    static constexpr bool PERM = true;
    const bf16_t* Y; bf16_t* Z; float* part;
    __device__ __forceinline__ void operator()(const f32x4 (&acc)[2][2][4][2], const Unit& u, int wr, int wc, int fr, int fq) const {
        asm volatile("" : "+v"(fr), "+v"(fq));
        const int row0 = u.pm * BM + wr * 64 + fr, col0 = u.pn * BM + wc * 32 + 8 * fq;
#pragma unroll
        for (int ai = 0; ai < 2; ++ai) {
            u32x4 yy[4][2];
#pragma unroll
            for (int m = 0; m < 4; ++m)
#pragma unroll
                for (int bj = 0; bj < 2; ++bj) yy[m][bj] = *(const u32x4*)(Y + (size_t)(row0 + ai * HALF + m * 16) * 512 + col0 + bj * HALF);
#pragma unroll
            for (int m = 0; m < 4; ++m) { const int row = row0 + ai * HALF + m * 16; float ss = 0.f;
#pragma unroll
                for (int bj = 0; bj < 2; ++bj) { const int col = col0 + bj * HALF;
                    const u32x4 yv = yy[m][bj];
                    const f32x4 a0 = acc[ai][bj][m][0], a1 = acc[ai][bj][m][1];
                    float v[8];
                    v[0] = bf_lo(yv.x) * sigmoidf_fast(a0[0]); v[1] = bf_hi(yv.x) * sigmoidf_fast(a0[1]);
                    v[2] = bf_lo(yv.y) * sigmoidf_fast(a0[2]); v[3] = bf_hi(yv.y) * sigmoidf_fast(a0[3]);
                    v[4] = bf_lo(yv.z) * sigmoidf_fast(a1[0]); v[5] = bf_hi(yv.z) * sigmoidf_fast(a1[1]);
                    v[6] = bf_lo(yv.w) * sigmoidf_fast(a1[2]); v[7] = bf_hi(yv.w) * sigmoidf_fast(a1[3]);
#pragma unroll
                    for (int e = 0; e < 8; ++e) ss += v[e] * v[e];
                    u32x4 w; w.x = cvt_pk_bf16(v[0], v[1]); w.y = cvt_pk_bf16(v[2], v[3]); w.z = cvt_pk_bf16(v[4], v[5]); w.w = cvt_pk_bf16(v[6], v[7]);
                    *(u32x4*)(Z + (size_t)row * 1024 + col) = w; }
                ss += __shfl_xor(ss, 16); ss += __shfl_xor(ss, 32);
                if (fq == 0) part[(size_t)row * 8 + u.pn * 4 + wc] = ss; }
            asm volatile("" ::: "memory");
        }
    }
};
template <bool BASE16> struct EpiRes {
    static constexpr bool PERM = false;
    const float* base; const bf16_t* base16; float* out; bf16_t* xb; float* part;
    __device__ __forceinline__ void operator()(const f32x4 (&acc)[2][2][4][2], const Unit& u, int wr, int wc, int fr, int fq) const {
        asm volatile("" : "+v"(fr), "+v"(fq));
        const int row0 = u.pm * BM + wr * 64 + fr, col0 = u.pn * BM + wc * 32 + 4 * fq;
#pragma unroll
        for (int ai = 0; ai < 2; ++ai) {
            f32x4 bv[4][2][2];
#pragma unroll
            for (int m = 0; m < 4; ++m) { const size_t off = (size_t)(row0 + ai * HALF + m * 16) * 1024 + col0;
#pragma unroll
                for (int bj = 0; bj < 2; ++bj)
#pragma unroll
                    for (int n = 0; n < 2; ++n) {
                        if constexpr (BASE16) { const u32x2 w = *(const u32x2*)(base16 + off + bj * HALF + n * 16); bv[m][bj][n] = (f32x4){bf_lo(w.x), bf_hi(w.x), bf_lo(w.y), bf_hi(w.y)}; }
                        else bv[m][bj][n] = *(const f32x4*)(base + off + bj * HALF + n * 16); } }
#pragma unroll
            for (int m = 0; m < 4; ++m) { const int row = row0 + ai * HALF + m * 16; float ss = 0.f; const size_t off = (size_t)row * 1024 + col0;
#pragma unroll
                for (int bj = 0; bj < 2; ++bj)
#pragma unroll
                    for (int n = 0; n < 2; ++n) { const size_t o2 = off + bj * HALF + n * 16;
                        const f32x4 v = bv[m][bj][n] + acc[ai][bj][m][n];
                        ss += (v[0] * v[0] + v[1] * v[1]) + (v[2] * v[2] + v[3] * v[3]);
                        if constexpr (BASE16) *(f32x4*)(out + o2) = v;
                        else { u32x2 w; w.x = cvt_pk_bf16(v[0], v[1]); w.y = cvt_pk_bf16(v[2], v[3]); *(u32x2*)(xb + o2) = w; } }
                ss += __shfl_xor(ss, 16); ss += __shfl_xor(ss, 32);
                if (fq == 0) part[(size_t)row * 16 + u.pn * 4 + wc] = ss; }
            asm volatile("" ::: "memory");
        }
    }
};
struct EpiGateUp {
    static constexpr bool PERM = true;
    bf16_t* H; const float* part; float eps;
    __device__ __forceinline__ void operator()(const f32x4 (&acc)[2][2][4][2], const Unit& u, int wr, int wc, int fr, int fq) const {
        asm volatile("" : "+v"(fr), "+v"(fq));
        const int row0 = u.pm * BM + wr * 64 + fr, col0 = u.pn * HALF + wc * 32 + 8 * fq;
#pragma unroll
        for (int ai = 0; ai < 2; ++ai) {
            f32x4 pv[4][4];
#pragma unroll
            for (int m = 0; m < 4; ++m) { const f32x4* pp = (const f32x4*)(part + (size_t)(row0 + ai * HALF + m * 16) * 16);
#pragma unroll
                for (int e = 0; e < 4; ++e) pv[m][e] = pp[e]; }
#pragma unroll
            for (int m = 0; m < 4; ++m) { const int row = row0 + ai * HALF + m * 16;
                const f32x4 p0 = pv[m][0], p1 = pv[m][1], p2 = pv[m][2], p3 = pv[m][3];
                const float s = ((p0[0] + p0[1]) + (p0[2] + p0[3])) + ((p1[0] + p1[1]) + (p1[2] + p1[3])) + ((p2[0] + p2[1]) + (p2[2] + p2[3])) + ((p3[0] + p3[1]) + (p3[2] + p3[3]));
                const float rs = 1.0f / sqrtf(s * (1.0f / 1024.0f) + eps);
                float v[8];
#pragma unroll
                for (int n = 0; n < 2; ++n)
#pragma unroll
                    for (int e = 0; e < 4; ++e) { const float g = acc[ai][0][m][n][e] * rs, up = acc[ai][1][m][n][e] * rs; v[n * 4 + e] = g * sigmoidf_fast(g) * up; }
                u32x4 w; w.x = cvt_pk_bf16(v[0], v[1]); w.y = cvt_pk_bf16(v[2], v[3]); w.z = cvt_pk_bf16(v[4], v[5]); w.w = cvt_pk_bf16(v[6], v[7]);
                *(u32x4*)(H + (size_t)row * 2816 + col0) = w; }
            asm volatile("" ::: "memory");
        }
    }
};

template <class Epi, class Sched, bool ALIGN_EPI, bool SP2, bool MID>
__device__ __forceinline__ void gemm_phase(PG8_LAS unsigned char* lds, const Gemm g, const Sched& S, const Epi& E, const float* midp, float mid_eps) {
    int tid = threadIdx.x; asm volatile("" : "+v"(tid));
    const int wid = __builtin_amdgcn_readfirstlane(tid >> 6), lane = tid & 63, wr = wid >> 2, wc = wid & 3, fr = lane & 15, fq = lane >> 4;
    const int K = g.K, nt = K / BK;
    unsigned voffA[2], voffB[2];
#pragma unroll
    for (int i = 0; i < 2; ++i) { int R, C; stage_rc(tid * 16 + i * 8192, R, C); const int Rb = Epi::PERM ? ((R & ~31) + perm32(R & 31)) : R;
        voffA[i] = (unsigned)(R * K + C) * 2u; voffB[i] = (unsigned)(Rb * K + C) * 2u; }
    const size_t kstep = (size_t)(BK * 2);
    const size_t hstep = (size_t)HALF * K * 2;
    const size_t tstep = 2 * hstep;
    const unsigned ldsw = (unsigned)wid * 1024u;
    const int aoff = lds_byte(wr * 64 + fr, fq * 8), boff = lds_byte(wc * 32 + fr, fq * 8);
#define PG8_SA(b, h) (((b) * 2 + (h)) * HTB)
#define PG8_SB(b, h) ((4 + (b) * 2 + (h)) * HTB)
#define PG8_STAGE(bufoff, gbase, voff) do { _Pragma("unroll") for (int _i = 0; _i < 2; ++_i) \
        __builtin_amdgcn_global_load_lds((const unsigned*)((const char*)(gbase) + (voff)[_i]), (PG8_LAS unsigned*)(lds + (bufoff) + ldsw + _i * 8192), 16, 0, 0); } while (0)
#define PG8_LDA(dst, b, h) do { _Pragma("unroll") for (int m = 0; m < 4; ++m) _Pragma("unroll") for (int k = 0; k < 2; ++k) dst[m][k] = *(const PG8_LAS bf16x8*)(lds + PG8_SA(b, h) + aoff + m * 2048 + k * 1024); } while (0)
#define PG8_LDB(dst, b, h) do { _Pragma("unroll") for (int n = 0; n < 2; ++n) _Pragma("unroll") for (int k = 0; k < 2; ++k) dst[n][k] = *(const PG8_LAS bf16x8*)(lds + PG8_SB(b, h) + boff + n * 2048 + k * 1024); } while (0)
#define PG8_MMA(ai, bj, At, Bt) do { __builtin_amdgcn_s_setprio(1); _Pragma("unroll") for (int m = 0; m < 4; ++m) _Pragma("unroll") for (int n = 0; n < 2; ++n) _Pragma("unroll") for (int k = 0; k < 2; ++k) \
        acc[ai][bj][m][n] = __builtin_amdgcn_mfma_f32_16x16x32_bf16(Bt[n][k], At[m][k], acc[ai][bj][m][n], 0, 0, 0); __builtin_amdgcn_s_setprio(0); } while (0)
#define PG8_WAIT_V(n) asm volatile("s_waitcnt vmcnt(" #n ")" ::: "memory")
#define PG8_WAIT_L(n) asm volatile("s_waitcnt lgkmcnt(" #n ")" ::: "memory")
#define PG8_BAR __builtin_amdgcn_s_barrier()
#define PG8_SCHED __builtin_amdgcn_sched_barrier(0)
    Unit cur, nxt; int ui = 0;
    if (!S.next(0, cur)) return;
    f32x4 acc[2][2][4][2];
#pragma unroll
    for (int a = 0; a < 2; ++a)
#pragma unroll
        for (int b = 0; b < 2; ++b)
#pragma unroll
            for (int m = 0; m < 4; ++m)
#pragma unroll
                for (int n = 0; n < 2; ++n) acc[a][b][m][n] = (f32x4){0.f, 0.f, 0.f, 0.f};
    bf16x8 At[4][2], B0[2][2], B1[2][2];
    const char* cA = (const char*)g.A + (size_t)cur.pm * tstep; const char* cB = (const char*)g.Bt + (size_t)cur.pn * tstep;
    if constexpr (SP2) {
        PG8_STAGE(PG8_SB(0, 0), cB, voffB); PG8_STAGE(PG8_SB(0, 1), cB + hstep, voffB); PG8_STAGE(PG8_SA(0, 0), cA, voffA); PG8_STAGE(PG8_SA(0, 1), cA + hstep, voffA);
        if (wr == 1) PG8_BAR;
        PG8_WAIT_V(2); PG8_BAR;
        PG8_STAGE(PG8_SB(1, 0), cB + kstep, voffB); PG8_STAGE(PG8_SA(1, 0), cA + kstep, voffA); PG8_STAGE(PG8_SB(1, 1), cB + hstep + kstep, voffB);
        PG8_WAIT_V(6); PG8_BAR;
    } else {
        PG8_STAGE(PG8_SB(0, 0), cB, voffB); PG8_STAGE(PG8_SA(0, 0), cA, voffA); PG8_STAGE(PG8_SB(0, 1), cB + hstep, voffB); PG8_STAGE(PG8_SA(0, 1), cA + hstep, voffA);
        if (wr == 1) PG8_BAR;
        PG8_WAIT_V(4); PG8_BAR;
        PG8_STAGE(PG8_SB(1, 0), cB + kstep, voffB); PG8_STAGE(PG8_SA(1, 0), cA + kstep, voffA); PG8_STAGE(PG8_SB(1, 1), cB + hstep + kstep, voffB);
        PG8_WAIT_V(6); PG8_BAR;
    }
    for (;;) {
        const bool has_next = S.next(ui + 1, nxt);
        const char* nA = has_next ? (const char*)g.A + (size_t)nxt.pm * tstep : cA; const char* nB = has_next ? (const char*)g.Bt + (size_t)nxt.pn * tstep : cB;
        for (int t = 0; t < nt; t += 2) {
            const bool last = (t == nt - 2);
            const char* a1 = cA + (size_t)(t + 1) * kstep;
            const char* a2 = last ? nA : cA + (size_t)(t + 2) * kstep; const char* b2 = last ? nB : cB + (size_t)(t + 2) * kstep;
            const char* a3 = a2 + kstep; const char* b3 = b2 + kstep;
            if constexpr (MID) {
                if (t == (nt >> 1)) {
                    PG8_SCHED;
                    f32x4 mp[2][4][2];
#pragma unroll
                    for (int ai = 0; ai < 2; ++ai)
#pragma unroll
                        for (int m = 0; m < 4; ++m) { const int row = cur.pm * BM + ai * HALF + wr * 64 + m * 16 + fr;
                            mp[ai][m][0] = *(const f32x4*)(midp + (size_t)row * 8); mp[ai][m][1] = *(const f32x4*)(midp + (size_t)row * 8 + 4); }
#pragma unroll
                    for (int ai = 0; ai < 2; ++ai)
#pragma unroll
                        for (int m = 0; m < 4; ++m) { const f32x4 p0 = mp[ai][m][0], p1 = mp[ai][m][1];
                            const float s = ((p0[0] + p0[1]) + (p0[2] + p0[3])) + ((p1[0] + p1[1]) + (p1[2] + p1[3]));
                            const float rs = 1.0f / sqrtf(s * (1.0f / 512.0f) + mid_eps);
#pragma unroll
                            for (int bj = 0; bj < 2; ++bj)
#pragma unroll
                                for (int n = 0; n < 2; ++n) acc[ai][bj][m][n] = acc[ai][bj][m][n] * rs; }
                    PG8_WAIT_V(0);
                    PG8_SCHED;
                }
            }
            if constexpr (SP2) {
            PG8_LDB(B0, 0, 0); PG8_LDB(B1, 0, 1); PG8_SCHED; PG8_LDA(At, 0, 0); PG8_STAGE(PG8_SA(1, 1), a1 + hstep, voffA);
            PG8_WAIT_V(8); PG8_WAIT_L(0); PG8_BAR; PG8_MMA(0, 0, At, B0); PG8_MMA(0, 1, At, B1); PG8_BAR; PG8_SCHED;
            PG8_LDA(At, 0, 1); PG8_STAGE(PG8_SB(0, 0), b2, voffB); PG8_STAGE(PG8_SB(0, 1), b2 + hstep, voffB); PG8_STAGE(PG8_SA(0, 0), a2, voffA);
            PG8_WAIT_V(8); PG8_WAIT_L(0); PG8_BAR; PG8_MMA(1, 0, At, B0); PG8_MMA(1, 1, At, B1); PG8_BAR; PG8_SCHED;
            PG8_LDB(B0, 1, 0); PG8_LDB(B1, 1, 1); PG8_SCHED; PG8_LDA(At, 1, 0); PG8_STAGE(PG8_SA(0, 1), a2 + hstep, voffA);
            PG8_WAIT_V(8); PG8_WAIT_L(0); PG8_BAR; PG8_MMA(0, 0, At, B0); PG8_MMA(0, 1, At, B1); PG8_BAR; PG8_SCHED;
            PG8_LDA(At, 1, 1); PG8_STAGE(PG8_SB(1, 0), b3, voffB); PG8_STAGE(PG8_SB(1, 1), b3 + hstep, voffB); PG8_STAGE(PG8_SA(1, 0), a3, voffA);
            PG8_WAIT_V(8); PG8_WAIT_L(0); PG8_BAR; PG8_MMA(1, 0, At, B0); PG8_MMA(1, 1, At, B1); PG8_BAR; PG8_SCHED;
            } else {
            PG8_LDB(B0, 0, 0); PG8_SCHED; PG8_LDA(At, 0, 0); PG8_STAGE(PG8_SA(1, 1), a1 + hstep, voffA);
            PG8_WAIT_L(8); PG8_BAR; PG8_WAIT_L(0); PG8_MMA(0, 0, At, B0); PG8_BAR; PG8_SCHED;
            PG8_LDB(B1, 0, 1); PG8_STAGE(PG8_SB(0, 0), b2, voffB);
            PG8_BAR; PG8_WAIT_L(0); PG8_MMA(0, 1, At, B1); PG8_BAR;
            PG8_LDA(At, 0, 1); PG8_STAGE(PG8_SA(0, 0), a2, voffA);
            PG8_BAR; PG8_WAIT_L(0); PG8_MMA(1, 0, At, B0); PG8_BAR; PG8_SCHED;
            PG8_STAGE(PG8_SB(0, 1), b2 + hstep, voffB);
            PG8_WAIT_V(6); PG8_BAR; PG8_MMA(1, 1, At, B1); PG8_BAR;
            PG8_LDB(B0, 1, 0); PG8_SCHED; PG8_LDA(At, 1, 0); PG8_STAGE(PG8_SA(0, 1), a2 + hstep, voffA);
            PG8_WAIT_L(8); PG8_BAR; PG8_WAIT_L(0); PG8_MMA(0, 0, At, B0); PG8_BAR; PG8_SCHED;
            PG8_LDB(B1, 1, 1); PG8_STAGE(PG8_SB(1, 0), b3, voffB);
            PG8_BAR; PG8_WAIT_L(0); PG8_MMA(0, 1, At, B1); PG8_BAR;
            PG8_LDA(At, 1, 1); PG8_STAGE(PG8_SA(1, 0), a3, voffA);
            PG8_BAR; PG8_WAIT_L(0); PG8_MMA(1, 0, At, B0); PG8_BAR; PG8_SCHED;
            PG8_STAGE(PG8_SB(1, 1), b3 + hstep, voffB);
            PG8_WAIT_V(6); PG8_BAR; PG8_MMA(1, 1, At, B1); PG8_BAR;
            }
        }
        if constexpr (ALIGN_EPI) { if (wr == 0) PG8_BAR; }
        E(acc, cur, wr, wc, fr, fq);
        if (!has_next) break;
#pragma unroll
        for (int a = 0; a < 2; ++a)
#pragma unroll
            for (int b = 0; b < 2; ++b)
#pragma unroll
                for (int m = 0; m < 4; ++m)
#pragma unroll
                    for (int n = 0; n < 2; ++n) acc[a][b][m][n] = (f32x4){0.f, 0.f, 0.f, 0.f};
        cur = nxt; cA = nA; cB = nB; ++ui;
        if constexpr (ALIGN_EPI) { if (wr == 1) PG8_BAR; }
    }
    PG8_WAIT_V(0);
    if constexpr (!ALIGN_EPI) { if (wr == 0) PG8_BAR; }
    PG8_BAR;
#undef PG8_SA
#undef PG8_SB
#undef PG8_STAGE
#undef PG8_LDA
#undef PG8_LDB
#undef PG8_MMA
#undef PG8_WAIT_V
#undef PG8_WAIT_L
#undef PG8_BAR
#undef PG8_SCHED
}
}

using pg8::bf16_t; using pg8::bf16x8; using pg8::f32x4; using pg8::u32x4; using pg8::u32x2; using pg8::cvt_pk_bf16;
typedef float f32x16 __attribute__((ext_vector_type(16)));
typedef short s16x4 __attribute__((ext_vector_type(4)));
constexpr int NB = 8, SEQ = 4096, DM = 1024, MTOK = NB * SEQ;
constexpr int NHEAD = 8, HD = 64, DATT = 512, DSSM = 512, NGRP = 32, GCH = 16, NST = 64, DFF = 2816;
constexpr int PROJ_LD = 1536;
constexpr int VT_LD = 32768 + 64;
constexpr float EPS = 1e-6f;
constexpr int NWAVES = 8, NTHR = 512;
constexpr int LDS_BYTES = 147456;
constexpr int MISC_OFF = 147456 - 512;

constexpr size_t MiB = 1u << 20;
constexpr size_t WS_CTL = 0, CTL_ZERO_BYTES = 65536;
constexpr int CW_BAR = 4096;
constexpr size_t WS_WIN = 1 * MiB;
constexpr size_t WS_WGLU = 5 * MiB;
constexpr size_t WS_WOUT = 6 * MiB;
constexpr size_t WS_WGU = 8 * MiB;
constexpr size_t WS_WDN = 20 * MiB;
constexpr size_t WS_SSM = 26 * MiB;
constexpr size_t WS_LAM16 = 34 * MiB;
constexpr size_t WS_PART1 = 35 * MiB;
constexpr size_t WS_PART2 = 36 * MiB;
constexpr size_t WS_PART3 = 38 * MiB;
constexpr size_t WS_XN = 48 * MiB;
constexpr size_t WS_Z = 112 * MiB;
constexpr size_t WS_VT = 176 * MiB;
constexpr size_t WS_PROJ = 210 * MiB;
constexpr size_t WS_YG = 306 * MiB;
constexpr size_t WS_H = 176 * MiB;
constexpr size_t WS_END = 352 * MiB;

__device__ __forceinline__ int crow(int r, int hi) { return (r & 3) + 8 * (r >> 2) + 4 * hi; }
__device__ __forceinline__ float2 cmul(float2 a, float2 b) { return make_float2(a.x * b.x - a.y * b.y, a.x * b.y + a.y * b.x); }
__device__ __forceinline__ unsigned short bf1(float v) { return (unsigned short)(cvt_pk_bf16(v, v) & 0xffffu); }
__device__ __forceinline__ float wave_sum(float v) {
#pragma unroll
    for (int o = 1; o < 64; o <<= 1) v += __shfl_xor(v, o);
    return v;
}

struct Args {
    const float* x; const float* norm1_g; const float* w_in; const float* attn_norm_g; const float* lambda_re; const float* lambda_im; const float* log_step;
    const float* b_re; const float* b_im; const float* c_re; const float* c_im; const float* d_skip; const float* w_glu; const float* ssm_norm_g; const float* w_out;
    const float* norm2_g; const float* w_gate; const float* w_up; const float* w_down; const float* final_norm_g;
    float* out; unsigned char* ws;
};

__device__ __forceinline__ void transpose_item(const float* W, int N, bf16_t* WT, int ldt, int k0, int n0, int drow0, int dcol0, const float* gk, float* scr, int lane) {
#pragma unroll 8
    for (int i = 0; i < 32; ++i) { const int kk = 2 * i + (lane >> 5); float v = W[(size_t)(k0 + kk) * N + n0 + (lane & 31)]; if (gk) v *= gk[k0 + kk]; scr[kk * 33 + (lane & 31)] = v; }
    asm volatile("s_waitcnt lgkmcnt(0)" ::: "memory");
    const int c = lane & 7;
#pragma unroll
    for (int j = 0; j < 4; ++j) { const int n = (lane >> 3) + 8 * j; const float* s = scr + (8 * c) * 33 + n;
        u32x4 o; o.x = cvt_pk_bf16(s[0 * 33], s[1 * 33]); o.y = cvt_pk_bf16(s[2 * 33], s[3 * 33]); o.z = cvt_pk_bf16(s[4 * 33], s[5 * 33]); o.w = cvt_pk_bf16(s[6 * 33], s[7 * 33]);
        *(u32x4*)(WT + (size_t)(drow0 + n) * ldt + dcol0 + 8 * c) = o; }
    asm volatile("s_waitcnt lgkmcnt(0)" ::: "memory");
}

__device__ __forceinline__ void ssm_mats(const Args& A, int g, char* lds) {
    float2* lamp = (float2*)lds;
    float2* bbm = lamp + 17 * 64;
    float2* cm = bbm + 1024;
    float* Kt = (float*)(cm + 1024);
    float2* fb = (float2*)(Kt + 4096);
    const int tid = threadIdx.x;
    bf16_t* WstT = (bf16_t*)(A.ws + WS_SSM + (size_t)g * 262144); bf16_t* KinT = WstT + 128 * 256; bf16_t* WinT = KinT + 256 * 256;
    if (tid < 64) { const int p = tid; const float lr = A.lambda_re[g * 64 + p], li = A.lambda_im[g * 64 + p]; const float dt = expf(A.log_step[g]);
        const float mag = expf(lr * dt), ang = li * dt; const float lbr = mag * cosf(ang), lbi = mag * sinf(ang);
        const float den = lr * lr + li * li, nr = lbr - 1.0f; fb[p] = make_float2((nr * lr + lbi * li) / den, (lbi * lr - nr * li) / den);
        float2 pw = make_float2(1.f, 0.f); const float2 lb = make_float2(lbr, lbi);
        for (int k = 0; k <= 16; ++k) { lamp[k * 64 + p] = pw; pw = cmul(pw, lb); }
        ((float2*)(A.ws + WS_LAM16))[g * 64 + p] = lamp[16 * 64 + p]; }
    __syncthreads();
    for (int idx = tid; idx < 1024; idx += NTHR) { { const int p = idx >> 4, h = idx & 15; const float br = A.b_re[(size_t)(g * 64 + p) * 16 + h], bi = A.b_im[(size_t)(g * 64 + p) * 16 + h]; const float2 f = fb[p];
            bbm[idx] = make_float2(f.x * br - f.y * bi, f.x * bi + f.y * br); }
        { const int h = idx >> 6, p = idx & 63; cm[idx] = make_float2(A.c_re[(size_t)(g * 16 + h) * 64 + p], A.c_im[(size_t)(g * 16 + h) * 64 + p]); } }
    __syncthreads();
    for (int idx = tid; idx < 4096; idx += NTHR) { const int tau = idx >> 8, h = (idx >> 4) & 15, hp = idx & 15; float s = 0.f;
        for (int p = 0; p < 64; ++p) { const float2 cl = cmul(cm[h * 64 + p], lamp[tau * 64 + p]); const float2 bq = bbm[p * 16 + hp]; s += cl.x * bq.x - cl.y * bq.y; }
        if (tau == 0 && h == hp) s += A.d_skip[g * 16 + h];
        Kt[idx] = s; }
    __syncthreads();
    for (int ch = tid; ch < 8192; ch += NTHR) { const int n = ch >> 5, kc = ch & 31, t = n >> 4, h = n & 15, s = kc >> 1, hp0 = (kc & 1) * 8; float v[8];
#pragma unroll
        for (int e = 0; e < 8; ++e) v[e] = (s <= t) ? Kt[((t - s) * 16 + h) * 16 + hp0 + e] : 0.f;
        u32x4 o; o.x = cvt_pk_bf16(v[0], v[1]); o.y = cvt_pk_bf16(v[2], v[3]); o.z = cvt_pk_bf16(v[4], v[5]); o.w = cvt_pk_bf16(v[6], v[7]);
        *(u32x4*)(KinT + (size_t)n * 256 + kc * 8) = o; }
    for (int ch = tid; ch < 4096; ch += NTHR) { const int n = ch >> 5, kc = ch & 31, nb = n >> 5, j = n & 31, p = 32 * (nb >> 1) + j, part = nb & 1, s = kc >> 1, hp0 = (kc & 1) * 8; float v[8];
        const float2 l = lamp[(15 - s) * 64 + p];
#pragma unroll
        for (int e = 0; e < 8; ++e) { const float2 w = cmul(l, bbm[p * 16 + hp0 + e]); v[e] = part ? w.y : w.x; }
        u32x4 o; o.x = cvt_pk_bf16(v[0], v[1]); o.y = cvt_pk_bf16(v[2], v[3]); o.z = cvt_pk_bf16(v[4], v[5]); o.w = cvt_pk_bf16(v[6], v[7]);
        *(u32x4*)(WstT + (size_t)n * 256 + kc * 8) = o; }
    for (int ch = tid; ch < 4096; ch += NTHR) { const int n = ch >> 4, kc = ch & 15, t = n >> 4, h = n & 15; float v[8];
#pragma unroll
        for (int e = 0; e < 8; ++e) { const int k2 = kc * 8 + e, nb2 = k2 >> 5, j2 = k2 & 31, p = 32 * (nb2 >> 1) + j2, part = nb2 & 1;
            const float2 w = cmul(cm[h * 64 + p], lamp[(t + 1) * 64 + p]); v[e] = part ? -w.y : w.x; }
        u32x4 o; o.x = cvt_pk_bf16(v[0], v[1]); o.y = cvt_pk_bf16(v[2], v[3]); o.z = cvt_pk_bf16(v[4], v[5]); o.w = cvt_pk_bf16(v[6], v[7]);
        *(u32x4*)(WinT + (size_t)n * 128 + kc * 8) = o; }
    __syncthreads();
}

__device__ __forceinline__ void p0_prologue(const Args& A, char* lds, int G) {
    const int tid = threadIdx.x, lane = tid & 63, wave = tid >> 6;
    const int bx = blockIdx.x;
    for (int g = bx; g < NGRP; g += G) ssm_mats(A, g, lds);
    float* scr = (float*)(lds + wave * 16384);
    const int gw = bx * NWAVES + wave, NGW = G * NWAVES;
    bf16_t* Win_t = (bf16_t*)(A.ws + WS_WIN); bf16_t* Wglu_t = (bf16_t*)(A.ws + WS_WGLU); bf16_t* Wout_t = (bf16_t*)(A.ws + WS_WOUT);
    bf16_t* Wgu_t = (bf16_t*)(A.ws + WS_WGU); bf16_t* Wdn_t = (bf16_t*)(A.ws + WS_WDN);
    constexpr int I_IN = 16 * 64, I_GLU = 8 * 16, I_OUT = 16 * 32, I_G = 16 * 88, I_U = 16 * 88, I_D = 44 * 32;
    constexpr int NITEMS = I_IN + I_GLU + I_OUT + I_G + I_U + I_D;
    for (int it = gw; it < NITEMS; it += NGW) {
        int r = it;
        if (r < I_IN) { const int kb = r / 64, nb = r % 64, n0 = 32 * nb; const int drow0 = (n0 < 1024) ? n0 : (n0 < 1536 ? n0 + 512 : n0 - 512);
            transpose_item(A.w_in, 2048, Win_t, 1024, 64 * kb, n0, drow0, 64 * kb, nullptr, scr, lane); continue; } r -= I_IN;
        if (r < I_GLU) { const int kb = r / 16, nb = r % 16; transpose_item(A.w_glu, 512, Wglu_t, 512, 64 * kb, 32 * nb, 32 * nb, 64 * kb, nullptr, scr, lane); continue; } r -= I_GLU;
        if (r < I_OUT) { const int kb = r / 32, nb = r % 32, k0 = 64 * kb; const bool ssm = k0 >= 512;
            transpose_item(A.w_out, 1024, Wout_t, 1024, k0, 32 * nb, 32 * nb, ssm ? k0 - 512 : k0 + 512, ssm ? (A.ssm_norm_g - 512) : A.attn_norm_g, scr, lane); continue; } r -= I_OUT;
        if (r < I_G) { const int kb = r / 88, nb = r % 88, n0 = 32 * nb; transpose_item(A.w_gate, DFF, Wgu_t, 1024, 64 * kb, n0, 256 * (n0 / 128) + (n0 % 128), 64 * kb, A.norm2_g, scr, lane); continue; } r -= I_G;
        if (r < I_U) { const int kb = r / 88, nb = r % 88, n0 = 32 * nb; transpose_item(A.w_up, DFF, Wgu_t, 1024, 64 * kb, n0, 256 * (n0 / 128) + 128 + (n0 % 128), 64 * kb, A.norm2_g, scr, lane); continue; } r -= I_U;
        { const int kb = r / 32, nb = r % 32; transpose_item(A.w_down, 1024, Wdn_t, DFF, 64 * kb, 32 * nb, 32 * nb, 64 * kb, nullptr, scr, lane); }
    }
    bf16_t* XN = (bf16_t*)(A.ws + WS_XN);
    f32x4 gv[4];
#pragma unroll
    for (int j = 0; j < 4; ++j) gv[j] = ((const f32x4*)A.norm1_g)[lane + 64 * j];
    const int nskip = (G > 2 * NGRP) ? NGRP : 0;
    if (bx >= nskip) {
        const int gw2 = (bx - nskip) * NWAVES + wave, NGW2 = (G - nskip) * NWAVES;
        for (int m = gw2; m < MTOK; m += 2 * NGW2) {
            const int m1 = m + NGW2; const bool has1 = m1 < MTOK;
            const f32x4* xr0 = (const f32x4*)(A.x + (size_t)m * DM) + lane; const f32x4* xr1 = (const f32x4*)(A.x + (size_t)(has1 ? m1 : m) * DM) + lane;
            f32x4 v0[4], v1[4]; float s0 = 0.f, s1 = 0.f;
#pragma unroll
            for (int j = 0; j < 4; ++j) { v0[j] = xr0[64 * j]; v1[j] = xr1[64 * j]; }
#pragma unroll
            for (int j = 0; j < 4; ++j) { s0 += (v0[j][0] * v0[j][0] + v0[j][1] * v0[j][1]) + (v0[j][2] * v0[j][2] + v0[j][3] * v0[j][3]); s1 += (v1[j][0] * v1[j][0] + v1[j][1] * v1[j][1]) + (v1[j][2] * v1[j][2] + v1[j][3] * v1[j][3]); }
            const float rs0 = 1.0f / sqrtf(wave_sum(s0) * (1.0f / DM) + EPS), rs1 = 1.0f / sqrtf(wave_sum(s1) * (1.0f / DM) + EPS);
            u32x2* o0 = (u32x2*)(XN + (size_t)m * DM) + lane;
#pragma unroll
            for (int j = 0; j < 4; ++j) { u32x2 w; w.x = cvt_pk_bf16(v0[j][0] * rs0 * gv[j][0], v0[j][1] * rs0 * gv[j][1]); w.y = cvt_pk_bf16(v0[j][2] * rs0 * gv[j][2], v0[j][3] * rs0 * gv[j][3]); o0[64 * j] = w; }
            if (has1) { u32x2* o1 = (u32x2*)(XN + (size_t)m1 * DM) + lane;
#pragma unroll
                for (int j = 0; j < 4; ++j) { u32x2 w; w.x = cvt_pk_bf16(v1[j][0] * rs1 * gv[j][0], v1[j][1] * rs1 * gv[j][1]); w.y = cvt_pk_bf16(v1[j][2] * rs1 * gv[j][2], v1[j][3] * rs1 * gv[j][3]); o1[64 * j] = w; } }
        }
    }
}

__device__ __forceinline__ float gelu_tanh(float y) {
    const float u = 0.7978845608028654f * (y + 0.044715f * y * y * y);
    return y * __builtin_amdgcn_rcpf(1.0f + __builtin_amdgcn_exp2f(-2.0f * 1.4426950408889634f * u));
}
template <int NCHUNK_PER_THREAD, int ROWB, int DSTRIDE>
__device__ __forceinline__ void lds_fill(char* dst, const bf16_t* src, int tid) {
    u32x4 v[NCHUNK_PER_THREAD];
#pragma unroll
    for (int i = 0; i < NCHUNK_PER_THREAD; ++i) v[i] = ((const u32x4*)src)[tid + i * NTHR];
#pragma unroll
    for (int i = 0; i < NCHUNK_PER_THREAD; ++i) { const int c = tid + i * NTHR, row = c / (ROWB / 16), col = c % (ROWB / 16); *(u32x4*)(dst + row * DSTRIDE + col * 16) = v[i]; }
}
__device__ __forceinline__ void ssm_item(const Args& A, int b, int g, char* lds) {
    const int tid = threadIdx.x, lane = tid & 63, w = __builtin_amdgcn_readfirstlane(tid >> 6), j = lane & 31, hi = lane >> 5;
    char* R2 = lds;
    float2* E = (float2*)lds;
    bf16_t* XS = (bf16_t*)(lds + 65536);
    float2* SEG = (float2*)(lds + 65536 + 69632);
    const bf16_t* PROJ = (const bf16_t*)(A.ws + WS_PROJ);
    const bf16_t* WstT = (const bf16_t*)(A.ws + WS_SSM + (size_t)g * 262144); const bf16_t* KinT = WstT + 128 * 256; const bf16_t* WinT = KinT + 256 * 256;
    const float2* LAM16 = (const float2*)(A.ws + WS_LAM16);
    bf16_t* YG = (bf16_t*)(A.ws + WS_YG);
    bf16x8 ua[16];
    { const bf16_t* up = PROJ + ((size_t)(b * SEQ + 16 * (32 * w + j))) * PROJ_LD + 1024 + g * 16 + 8 * hi;
#pragma unroll
      for (int tl = 0; tl < 16; ++tl) ua[tl] = *(const bf16x8*)(up + (size_t)tl * PROJ_LD); }
#pragma unroll 1
    for (int hp = 0; hp < 2; ++hp) {
        lds_fill<4, 512, 528>(R2, WstT + (size_t)64 * hp * 256, tid);
        __syncthreads();
        f32x16 are = {}, aim = {};
        const char* bl = R2 + j * 528 + hi * 16;
#pragma unroll
        for (int ks = 0; ks < 16; ++ks) { const bf16x8 br = *(const bf16x8*)(bl + ks * 32), bi = *(const bf16x8*)(bl + 32 * 528 + ks * 32);
            are = __builtin_amdgcn_mfma_f32_32x32x16_bf16(ua[ks], br, are, 0, 0, 0); aim = __builtin_amdgcn_mfma_f32_32x32x16_bf16(ua[ks], bi, aim, 0, 0, 0); }
        __syncthreads();
#pragma unroll
        for (int r = 0; r < 16; ++r) E[(32 * w + crow(r, hi)) * 32 + j] = make_float2(are[r], aim[r]);
        __syncthreads();
        { const int seg = tid >> 5, pl = tid & 31; const float2 l16 = LAM16[g * 64 + 32 * hp + pl];
          float2 x = make_float2(0.f, 0.f);
#pragma unroll
          for (int i = 0; i < 16; ++i) { const float2 e = E[(16 * seg + i) * 32 + pl]; const float2 t = cmul(l16, x); x = make_float2(t.x + e.x, t.y + e.y); }
          SEG[seg * 32 + pl] = x;
          __syncthreads();
          float2 l256 = l16;
#pragma unroll
          for (int q = 0; q < 4; ++q) l256 = cmul(l256, l256);
          float2 xs = make_float2(0.f, 0.f);
          for (int s2 = 0; s2 < seg; ++s2) { const float2 e = SEG[s2 * 32 + pl]; const float2 t = cmul(l256, xs); xs = make_float2(t.x + e.x, t.y + e.y); }
          x = xs;
#pragma unroll
          for (int i = 0; i < 16; ++i) { const int c = 16 * seg + i; XS[c * 136 + 64 * hp + pl] = bf1(x.x); XS[c * 136 + 64 * hp + 32 + pl] = bf1(x.y);
              const float2 e = E[c * 32 + pl]; const float2 t = cmul(l16, x); x = make_float2(t.x + e.x, t.y + e.y); } }
        __syncthreads();
    }
#pragma unroll 1
    for (int qd = 0; qd < 4; ++qd) {
        lds_fill<4, 512, 528>(R2, KinT + (size_t)64 * qd * 256, tid);
        lds_fill<2, 256, 272>(R2 + 33792, WinT + (size_t)64 * qd * 128, tid);
        __syncthreads();
        f32x16 acc[2]; acc[0] = f32x16{}; acc[1] = f32x16{};
        const char* kl = R2 + j * 528 + hi * 16;
#pragma unroll
        for (int ks = 0; ks < 16; ++ks)
#pragma unroll
            for (int q = 0; q < 2; ++q) { if (ks <= 2 * (2 * qd + q) + 1) {
                    const bf16x8 bv = *(const bf16x8*)(kl + q * 32 * 528 + ks * 32); acc[q] = __builtin_amdgcn_mfma_f32_32x32x16_bf16(ua[ks], bv, acc[q], 0, 0, 0); } }
        const char* wl = R2 + 33792 + j * 272 + hi * 16;
#pragma unroll
        for (int k2 = 0; k2 < 8; ++k2) { const bf16x8 av = *(const bf16x8*)(XS + (32 * w + j) * 136 + 16 * k2 + 8 * hi);
#pragma unroll
            for (int q = 0; q < 2; ++q) { const bf16x8 bv = *(const bf16x8*)(wl + q * 32 * 272 + k2 * 32); acc[q] = __builtin_amdgcn_mfma_f32_32x32x16_bf16(av, bv, acc[q], 0, 0, 0); } }
#pragma unroll
        for (int q = 0; q < 2; ++q) { const int n = 64 * qd + 32 * q + j, t = n >> 4, h = n & 15;
#pragma unroll
            for (int r = 0; r < 16; ++r) { const int c = 32 * w + crow(r, hi); const int tok = 16 * c + t;
                YG[(size_t)(b * SEQ + tok) * DSSM + g * 16 + h] = bf1(gelu_tanh(acc[q][r])); } }
        __syncthreads();
    }
}

constexpr float ATT_SC = 0.125f * 1.4426950408889634f;
constexpr float ATT_STOP = 160.0f;
struct KVTile { bf16x8 kf[4]; s16x4 va[2][2], vb[2][2]; };
__device__ __forceinline__ void kv_load(KVTile& t, const bf16_t* kbase, const bf16_t* vbase, int kt, int j) {
    const int k0 = 32 * kt; const bf16_t* kp = kbase + (size_t)(k0 + j) * PROJ_LD;
#pragma unroll
    for (int d0 = 0; d0 < 4; ++d0) t.kf[d0] = *(const bf16x8*)(kp + 16 * d0);
#pragma unroll
    for (int db = 0; db < 2; ++db)
#pragma unroll
        for (int ks = 0; ks < 2; ++ks) { const bf16_t* vp = vbase + (size_t)db * 32 * VT_LD + k0 + 16 * ks; t.va[db][ks] = *(const s16x4*)(vp); t.vb[db][ks] = *(const s16x4*)(vp + 8); }
}
__device__ __forceinline__ void attn_tile(const KVTile& t, const bf16x8 (&qf)[4], f32x16& o0, f32x16& o1, float& R2, bool diag, int j, int hi) {
    f32x16 s = {};
#pragma unroll
    for (int d0 = 0; d0 < 4; ++d0) s = __builtin_amdgcn_mfma_f32_32x32x16_bf16(t.kf[d0], qf[d0], s, 0, 0, 0);
    float L[16], z2[16];
#pragma unroll
    for (int r = 0; r < 16; ++r) { const float z = s[r] * ATT_SC; const float e = __builtin_amdgcn_exp2f(-fabsf(z));
        const float l = fmaxf(z, 0.f) + __builtin_amdgcn_logf(1.0f + e);
        const bool msk = diag && (crow(r, hi) >= j); L[r] = msk ? 0.f : l; z2[r] = msk ? -1e30f : z; }
    float gs[4], pg[4];
#pragma unroll
    for (int g4 = 0; g4 < 4; ++g4) { gs[g4] = (L[4 * g4] + L[4 * g4 + 1]) + (L[4 * g4 + 2] + L[4 * g4 + 3]); pg[g4] = __shfl_xor(gs[g4], 32); }
    float T[4]; T[3] = 0.f; T[2] = gs[3] + pg[3]; T[1] = T[2] + (gs[2] + pg[2]); T[0] = T[1] + (gs[1] + pg[1]);
    const float total = T[0] + (gs[0] + pg[0]);
    float wv[16];
#pragma unroll
    for (int g4 = 0; g4 < 4; ++g4) { const float after = T[g4] + (hi == 0 ? pg[g4] : 0.f) + R2;
        const float s3 = after, s2 = s3 + L[4 * g4 + 3], s1 = s2 + L[4 * g4 + 2], s0 = s1 + L[4 * g4 + 1];
        wv[4 * g4 + 3] = __builtin_amdgcn_exp2f(z2[4 * g4 + 3] - L[4 * g4 + 3] - s3);
        wv[4 * g4 + 2] = __builtin_amdgcn_exp2f(z2[4 * g4 + 2] - L[4 * g4 + 2] - s2);
        wv[4 * g4 + 1] = __builtin_amdgcn_exp2f(z2[4 * g4 + 1] - L[4 * g4 + 1] - s1);
        wv[4 * g4 + 0] = __builtin_amdgcn_exp2f(z2[4 * g4 + 0] - L[4 * g4 + 0] - s0); }
    R2 += total;
    u32x4 p0, p1;
    p0.x = cvt_pk_bf16(wv[0], wv[1]); p0.y = cvt_pk_bf16(wv[2], wv[3]); p0.z = cvt_pk_bf16(wv[4], wv[5]); p0.w = cvt_pk_bf16(wv[6], wv[7]);
    p1.x = cvt_pk_bf16(wv[8], wv[9]); p1.y = cvt_pk_bf16(wv[10], wv[11]); p1.z = cvt_pk_bf16(wv[12], wv[13]); p1.w = cvt_pk_bf16(wv[14], wv[15]);
    const bf16x8 pa0 = __builtin_bit_cast(bf16x8, p0), pa1 = __builtin_bit_cast(bf16x8, p1);
    bf16x8 vf[2][2];
#pragma unroll
    for (int db = 0; db < 2; ++db)
#pragma unroll
        for (int ks = 0; ks < 2; ++ks) vf[db][ks] = (bf16x8){t.va[db][ks][0], t.va[db][ks][1], t.va[db][ks][2], t.va[db][ks][3], t.vb[db][ks][0], t.vb[db][ks][1], t.vb[db][ks][2], t.vb[db][ks][3]};
    o0 = __builtin_amdgcn_mfma_f32_32x32x16_bf16(pa0, vf[0][0], o0, 0, 0, 0); o0 = __builtin_amdgcn_mfma_f32_32x32x16_bf16(pa1, vf[0][1], o0, 0, 0, 0);
    o1 = __builtin_amdgcn_mfma_f32_32x32x16_bf16(pa0, vf[1][0], o1, 0, 0, 0); o1 = __builtin_amdgcn_mfma_f32_32x32x16_bf16(pa1, vf[1][1], o1, 0, 0, 0);
}
__device__ __forceinline__ void attn_item(const Args& A, int b, int qt, char* lds) {
    const int tid = threadIdx.x, lane = tid & 63, h = __builtin_amdgcn_readfirstlane(tid >> 6), j = lane & 31, hi = lane >> 5;
    float* OST = (float*)lds + h * (32 * 68);
    float* PART = (float*)(lds + 69632);
    const bf16_t* PROJ = (const bf16_t*)(A.ws + WS_PROJ);
    const bf16_t* VT = (const bf16_t*)(A.ws + WS_VT);
    bf16_t* Z = (bf16_t*)(A.ws + WS_Z);
    const int q0 = 32 * qt; const size_t rowbase = (size_t)b * SEQ;
    const bf16_t* kbase = PROJ + rowbase * PROJ_LD + 512 + h * 64 + 8 * hi;
    const bf16_t* vbase = VT + (size_t)(h * 64 + j) * VT_LD + rowbase + 4 * hi;
    KVTile t0, t1, t2;
    kv_load(t0, kbase, vbase, qt, j);
    bf16x8 qf[4];
    { const bf16_t* qp = PROJ + (rowbase + q0 + j) * PROJ_LD + h * 64 + 8 * hi;
#pragma unroll
      for (int d0 = 0; d0 < 4; ++d0) qf[d0] = *(const bf16x8*)(qp + 16 * d0); }
    kv_load(t1, kbase, vbase, qt > 1 ? qt - 1 : 0, j);
    kv_load(t2, kbase, vbase, qt > 2 ? qt - 2 : 0, j);
    f32x16 o0 = {}, o1 = {}; float R2 = 0.f;
    for (int kt = qt;;) {
        attn_tile(t0, qf, o0, o1, R2, kt == qt, j, hi); if (kt == 0 || __all(R2 > ATT_STOP)) break; kv_load(t0, kbase, vbase, kt > 3 ? kt - 3 : 0, j); --kt;
        attn_tile(t1, qf, o0, o1, R2, false, j, hi);    if (kt == 0 || __all(R2 > ATT_STOP)) break; kv_load(t1, kbase, vbase, kt > 3 ? kt - 3 : 0, j); --kt;
        attn_tile(t2, qf, o0, o1, R2, false, j, hi);    if (kt == 0 || __all(R2 > ATT_STOP)) break; kv_load(t2, kbase, vbase, kt > 3 ? kt - 3 : 0, j); --kt;
    }
#pragma unroll
    for (int r = 0; r < 16; ++r) { OST[crow(r, hi) * 68 + j] = o0[r]; OST[crow(r, hi) * 68 + 32 + j] = o1[r]; }
    asm volatile("s_waitcnt lgkmcnt(0)" ::: "memory");
    f32x4 ov[8]; float ss = 0.f;
#pragma unroll
    for (int e = 0; e < 8; ++e) { ov[e] = *(const f32x4*)(OST + j * 68 + 32 * hi + 4 * e); ss += (ov[e][0] * ov[e][0] + ov[e][1] * ov[e][1]) + (ov[e][2] * ov[e][2] + ov[e][3] * ov[e][3]); }
    PART[(h * 32 + j) * 2 + hi] = ss;
    __syncthreads();
    float tot = 0.f;
#pragma unroll
    for (int w2 = 0; w2 < 8; ++w2) { tot += PART[(w2 * 32 + j) * 2] + PART[(w2 * 32 + j) * 2 + 1]; }
    const float rs = 1.0f / sqrtf(tot * (1.0f / DATT) + EPS);
    bf16_t* zp = Z + (rowbase + q0 + j) * 1024 + 512 + h * 64 + 32 * hi;
#pragma unroll
    for (int e = 0; e < 4; ++e) { const f32x4 a = ov[2 * e] * rs, c = ov[2 * e + 1] * rs; u32x4 w;
        w.x = cvt_pk_bf16(a[0], a[1]); w.y = cvt_pk_bf16(a[2], a[3]); w.z = cvt_pk_bf16(c[0], c[1]); w.w = cvt_pk_bf16(c[2], c[3]); *(u32x4*)(zp + 8 * e) = w; }
    __syncthreads();
}


#define LAS __attribute__((address_space(3)))
#define XB_TMO      128
#define XB_XCNT(j)  (256  + 64 * (j))
#define XB_XSUB(j)  (1280 + 64 * (j))
#define XB_XGEN(j)  (2304 + 64 * (j))
#define XB_TOP      3328
#define XB_TOPGEN   3392
#define XCD_BAR_WORDS 3456
#define XB_SPIN_CAP (1u << 18)
__device__ __forceinline__ unsigned xb_ld(unsigned* p)              { return __hip_atomic_load(p, __ATOMIC_RELAXED, __HIP_MEMORY_SCOPE_AGENT); }
__device__ __forceinline__ unsigned xb_add(unsigned* p, unsigned v) { return __hip_atomic_fetch_add(p, v, __ATOMIC_RELAXED, __HIP_MEMORY_SCOPE_AGENT); }
__device__ __forceinline__ unsigned xb_xcc_id() { return (unsigned)__builtin_amdgcn_s_getreg((3 << 11) | 20) & 0xFu; }
#define XB_SPIN(cond, bar) do { unsigned _sp = 0; while (cond) { __builtin_amdgcn_s_sleep(1); \
    if ((++_sp & 255u) == 0u) { if (xb_ld(&(bar)[XB_TMO])) break; if (_sp > XB_SPIN_CAP) { atomicAdd(&(bar)[XB_TMO], 1u); break; } } } } while (0)
struct XcdBarrier { unsigned* bar; unsigned x; volatile LAS unsigned* st; };
__device__ __forceinline__ XcdBarrier xcd_barrier_post(unsigned* bar, volatile LAS unsigned* st) {
    XcdBarrier b; b.bar = bar; b.x = xb_xcc_id(); b.st = st;
    if (threadIdx.x == 0) (void)xb_add(&bar[XB_XCNT(b.x)], 1u);
    return b;
}
__device__ __forceinline__ void xcd_barrier_complete(unsigned* bar, unsigned x, unsigned& nloc, unsigned& nx) {
    const unsigned G = gridDim.x * gridDim.y * gridDim.z;
    unsigned sum, cnt, mine, sp = 0u;
    for (;;) {
        sum = 0u; cnt = 0u; mine = 0u;
#pragma unroll
        for (unsigned j = 0; j < 16; ++j) { const unsigned c = xb_ld(&bar[XB_XCNT(j)]); sum += c; cnt += (c > 0u) ? 1u : 0u; mine = (j == x) ? c : mine; }
        if (sum == G) break;
        __builtin_amdgcn_s_sleep(1);
        if ((++sp & 255u) == 0u) { if (xb_ld(&bar[XB_TMO])) break; if (sp > XB_SPIN_CAP) { atomicAdd(&bar[XB_TMO], 1u); break; } }
    }
    nloc = mine > 0u ? mine : 1u; nx = cnt > 0u ? cnt : 1u;
}
__device__ __forceinline__ void xcd_barrier(const XcdBarrier& b) {
    asm volatile("s_waitcnt vmcnt(0)" ::: "memory");
    __syncthreads();
    if (threadIdx.x == 0) {
        unsigned* bar = b.bar;
        __builtin_amdgcn_s_waitcnt(0);
        unsigned nloc = b.st[0], nx = b.st[1];
        if (nloc == 0u) { xcd_barrier_complete(bar, b.x, nloc, nx); b.st[0] = nloc; b.st[1] = nx; }
        const unsigned old = xb_add(&bar[XB_XSUB(b.x)], 1u);
        const unsigned gen = old / nloc;
        if (old + 1u == (gen + 1u) * nloc) {
            __builtin_amdgcn_fence(__ATOMIC_RELEASE, "agent");
            asm volatile("s_waitcnt vmcnt(0)" ::: "memory");
            const unsigned og = xb_add(&bar[XB_TOP], 1u);
            const unsigned tg = og / nx;
            if (og + 1u == (tg + 1u) * nx) xb_add(&bar[XB_TOPGEN], 1u);
            else XB_SPIN(xb_ld(&bar[XB_TOPGEN]) == tg, bar);
            __builtin_amdgcn_fence(__ATOMIC_ACQUIRE, "agent");
            xb_add(&bar[XB_XGEN(b.x)], 1u);
            asm volatile("s_waitcnt vmcnt(0)" ::: "memory");
        } else {
            XB_SPIN(xb_ld(&bar[XB_XGEN(b.x)]) == gen, bar);
            __builtin_amdgcn_fence(__ATOMIC_ACQUIRE, "agent");
            asm volatile("s_waitcnt vmcnt(0)" ::: "memory");
        }
    }
    __syncthreads();
}

__global__ void __launch_bounds__(NTHR, 2) hymba_fwd(Args A) {
    extern __shared__ __attribute__((aligned(16))) unsigned char lds[];
    cg::grid_group grid = cg::this_grid();
    const int G = gridDim.x, bx = blockIdx.x;
    PG8_LAS unsigned char* lds3 = (PG8_LAS unsigned char*)lds;
    volatile LAS unsigned* MISC = (volatile LAS unsigned*)(lds3 + MISC_OFF);
    if (threadIdx.x < 32) MISC[threadIdx.x] = 0u;
    __syncthreads();
    XcdBarrier bar = xcd_barrier_post((unsigned*)(A.ws + WS_CTL) + CW_BAR, MISC + 8);
#ifdef PROBE_A
    volatile LAS unsigned long long* STAMP = (volatile LAS unsigned long long*)(lds3 + MISC_OFF + 128);
#define STAMPIT(i) do { if (threadIdx.x == 0) STAMP[i] = __builtin_amdgcn_s_memrealtime(); } while (0)
#ifndef PROBE_BX
#define PROBE_BX 0
#endif
#else
#define STAMPIT(i) do {} while (0)
#endif
    STAMPIT(0);

#ifndef NO_P0
    p0_prologue(A, (char*)lds, G);
#endif
    if (A.ws == nullptr) grid.sync();
    xcd_barrier(bar);
    STAMPIT(1);

#ifndef NO_P1
    {
        pg8::Gemm g{(const bf16_t*)(A.ws + WS_XN), (const bf16_t*)(A.ws + WS_WIN), MTOK, 1536, DM}; pg8::StaticOrder S; S.init(MTOK, 1536, G, bx);
        pg8::EpiStore E{(bf16_t*)(A.ws + WS_PROJ), PROJ_LD};
        pg8::gemm_phase<pg8::EpiStore, pg8::StaticOrder, true, true, false>(lds3, g, S, E, nullptr, 0.f);
        pg8::Gemm g2{(const bf16_t*)(A.ws + WS_WIN) + (size_t)1536 * DM, (const bf16_t*)(A.ws + WS_XN), 512, MTOK, DM}; pg8::StaticOrder S2; S2.init(512, MTOK, G, bx);
        pg8::EpiStore E2{(bf16_t*)(A.ws + WS_VT), VT_LD};
        pg8::gemm_phase<pg8::EpiStore, pg8::StaticOrder, true, true, false>(lds3, g2, S2, E2, nullptr, 0.f);
    }
#endif
    xcd_barrier(bar);
    STAMPIT(2);

#ifndef NO_SSM
    for (int it = bx; it < NB * NGRP; it += G) ssm_item(A, it >> 5, it & 31, (char*)lds);
#endif
    STAMPIT(9);
#ifndef NO_ATT
    for (int it = bx; it < NB * (SEQ / 32); it += G) attn_item(A, it >> 7, it & 127, (char*)lds);
#endif
    STAMPIT(10);
    xcd_barrier(bar);
    STAMPIT(3);

#ifndef NO_P3
    {
        pg8::Gemm g{(const bf16_t*)(A.ws + WS_YG), (const bf16_t*)(A.ws + WS_WGLU), MTOK, 512, 512}; pg8::StaticOrder S; S.init(MTOK, 512, G, bx);
        pg8::EpiGlu E{(const bf16_t*)(A.ws + WS_YG), (bf16_t*)(A.ws + WS_Z), (float*)(A.ws + WS_PART1)};
        pg8::gemm_phase<pg8::EpiGlu, pg8::StaticOrder, true, true, false>(lds3, g, S, E, nullptr, 0.f);
    }
#endif
    xcd_barrier(bar);
    STAMPIT(4);

#ifndef NO_P4
    {
        pg8::Gemm g{(const bf16_t*)(A.ws + WS_Z), (const bf16_t*)(A.ws + WS_WOUT), MTOK, DM, DM}; pg8::StaticOrder S; S.init(MTOK, DM, G, bx);
        pg8::EpiRes<false> E{A.x, nullptr, nullptr, (bf16_t*)(A.ws + WS_XN), (float*)(A.ws + WS_PART2)};
        pg8::gemm_phase<pg8::EpiRes<false>, pg8::StaticOrder, true, true, true>(lds3, g, S, E, (const float*)(A.ws + WS_PART1), EPS);
    }
#endif
    xcd_barrier(bar);
    STAMPIT(5);

#ifndef NO_P5
    {
        pg8::Gemm g{(const bf16_t*)(A.ws + WS_XN), (const bf16_t*)(A.ws + WS_WGU), MTOK, 2 * DFF, DM}; pg8::StaticOrder S; S.init(MTOK, 2 * DFF, G, bx);
        pg8::EpiGateUp E{(bf16_t*)(A.ws + WS_H), (const float*)(A.ws + WS_PART2), EPS};
        pg8::gemm_phase<pg8::EpiGateUp, pg8::StaticOrder, true, true, false>(lds3, g, S, E, nullptr, 0.f);
    }
#endif
    xcd_barrier(bar);
    STAMPIT(6);

#ifndef NO_P6
    {
        pg8::Gemm g{(const bf16_t*)(A.ws + WS_H), (const bf16_t*)(A.ws + WS_WDN), MTOK, DM, DFF}; pg8::StaticOrder S; S.init(MTOK, DM, G, bx);
        pg8::EpiRes<true> E{nullptr, (const bf16_t*)(A.ws + WS_XN), A.out, nullptr, (float*)(A.ws + WS_PART3)};
        pg8::gemm_phase<pg8::EpiRes<true>, pg8::StaticOrder, true, true, false>(lds3, g, S, E, nullptr, 0.f);
    }
#endif
    xcd_barrier(bar);
    STAMPIT(7);

    {
        int tid7 = threadIdx.x; asm volatile("" : "+v"(tid7));
        const int wave = tid7 >> 6, lane = tid7 & 63;
        const int gw = bx * NWAVES + wave, NGW = G * NWAVES;
        f32x4 gv[4];
#pragma unroll
        for (int j = 0; j < 4; ++j) gv[j] = ((const f32x4*)A.final_norm_g)[lane + 64 * j];
        const float* part = (const float*)(A.ws + WS_PART3);
        for (int m = gw; m < MTOK; m += NGW) {
            const f32x4* pp = (const f32x4*)(part + (size_t)m * 16); const f32x4 p0 = pp[0], p1 = pp[1], p2 = pp[2], p3 = pp[3];
            const float s = ((p0[0] + p0[1]) + (p0[2] + p0[3])) + ((p1[0] + p1[1]) + (p1[2] + p1[3])) + ((p2[0] + p2[1]) + (p2[2] + p2[3])) + ((p3[0] + p3[1]) + (p3[2] + p3[3]));
            const float rs = 1.0f / sqrtf(s * (1.0f / DM) + EPS);
            f32x4* xr = (f32x4*)(A.out + (size_t)m * DM) + lane;
#pragma unroll
            for (int j = 0; j < 4; ++j) { const f32x4 v = xr[64 * j]; xr[64 * j] = v * rs * gv[j]; }
        }
    }
#ifdef PROBE_A
    STAMPIT(8);
    if (bx == PROBE_BX && threadIdx.x == 0) { const unsigned long long dt = STAMP[PROBE_B] - STAMP[PROBE_A]; const unsigned long long t0 = __builtin_amdgcn_s_memrealtime(); while (__builtin_amdgcn_s_memrealtime() - t0 < dt) __builtin_amdgcn_s_sleep(8); }
#endif
}

extern "C" void kernel_launch(void* const* d_in, const int* in_sizes, int n_in, void* d_out, int out_size, void* d_ws, size_t ws_size, hipStream_t stream) {
    static int grid = 0;
    if (grid == 0) {
        if (n_in != 20 || in_sizes[0] != MTOK * DM || out_size != MTOK * DM || ws_size < WS_END) { fprintf(stderr, "kernel_launch: unexpected problem shape / workspace (%d inputs, ws %zu)\n", n_in, ws_size); grid = -1; return; }
        int dev = 0, cus = 0, per_cu = 0;
        if (hipGetDevice(&dev) != hipSuccess || hipDeviceGetAttribute(&cus, hipDeviceAttributeMultiprocessorCount, dev) != hipSuccess) { grid = -1; return; }
        if (hipFuncSetAttribute((const void*)hymba_fwd, hipFuncAttributeMaxDynamicSharedMemorySize, LDS_BYTES) != hipSuccess) { fprintf(stderr, "kernel_launch: hipFuncSetAttribute failed\n"); grid = -1; return; }
        if (hipOccupancyMaxActiveBlocksPerMultiprocessor(&per_cu, (const void*)hymba_fwd, NTHR, LDS_BYTES) != hipSuccess || per_cu < 1) { fprintf(stderr, "kernel_launch: occupancy query says %d\n", per_cu); per_cu = 1; }
        (void)hipGetLastError();
        grid = cus * 1;
    }
    if (grid < 0) return;
    if (hipMemsetAsync((char*)d_ws + WS_CTL, 0, CTL_ZERO_BYTES, stream) != hipSuccess) { fprintf(stderr, "kernel_launch: memset failed\n"); return; }
    Args a{};
    const float** f = (const float**)&a;
    for (int i = 0; i < 20; ++i) f[i] = (const float*)d_in[i];
    a.out = (float*)d_out; a.ws = (unsigned char*)d_ws;
    void* args[] = {&a};
    hipError_t e = hipLaunchCooperativeKernel((const void*)hymba_fwd, dim3(grid), dim3(NTHR), args, LDS_BYTES, stream);
    if (e != hipSuccess) fprintf(stderr, "cooperative launch failed: %s (grid %d)\n", hipGetErrorString(e), grid);
}
```

```cpp
#include <hip/hip_runtime.h>
#include <hip/hip_cooperative_groups.h>
#include <cstdio>
#include <cstdint>
namespace cg = cooperative_groups;

namespace pg8 {
#define PG8_LAS __attribute__((address_space(3)))
typedef unsigned short bf16_t;
typedef short bf16x8 __attribute__((ext_vector_type(8)));
typedef float f32x4 __attribute__((ext_vector_type(4)));
typedef float f32x2 __attribute__((ext_vector_type(2)));
typedef unsigned u32x4 __attribute__((ext_vector_type(4)));
typedef unsigned u32x2 __attribute__((ext_vector_type(2)));
constexpr int BM = 256, BK = 64, HALF = 128, HTB = HALF * BK * 2, STAGE_BYTES = 8 * HTB, NXCD = 8, WGM = 8;

__host__ __device__ __forceinline__ int lds_byte(int r, int c) { const int st = (r >> 4) * 2 + (c >> 5), rr = r & 15, cc = c & 31, ob = rr * 64 + cc * 2; return st * 1024 + (ob ^ (((ob >> 9) & 1) << 5)); }
__host__ __device__ __forceinline__ void stage_rc(int b, int& R, int& C) { const int st = b / 1024, sb = b % 1024, swz = sb ^ (((sb >> 9) & 1) << 5); R = (st >> 1) * 16 + swz / 64; C = (st & 1) * 32 + (swz % 64) / 2; }
__host__ __device__ __forceinline__ int perm32(int rho) { const int n = rho >> 4, i = rho & 15; return 8 * (i >> 2) + 4 * n + (i & 3); }

struct Unit { int pm, pn; };
struct Gemm { const bf16_t* A; const bf16_t* Bt; int M, N, K; };

struct StaticOrder {
    int nM, nN, nwg, G, c;
    __host__ __device__ void init(int M, int N, int G_, int c_) { nM = M / BM; nN = N / BM; nwg = nM * nN; G = G_; c = c_; }
    __host__ __device__ bool next(int i, Unit& u) const {
        const long L = (long)i * G + c; if (L >= nwg) return false;
        int wgid = (int)L; { const int q = nwg / NXCD, r = nwg % NXCD, xcd = wgid % NXCD, off = wgid / NXCD; wgid = (xcd < r ? xcd * (q + 1) : r * (q + 1) + (xcd - r) * q) + off; }
        const int nig = WGM * nN, gid = wgid / nig, fm = gid * WGM, gsz = (nM - fm) < WGM ? (nM - fm) : WGM;
        u.pm = fm + ((wgid % nig) % gsz); u.pn = (wgid % nig) / gsz; return true;
    }
    __device__ __forceinline__ void a_ready(const Unit&) const {}
    __device__ __forceinline__ void done(const Unit&) const {}
};

__device__ __forceinline__ unsigned cvt_pk_bf16(float lo, float hi) { unsigned r; asm volatile("v_cvt_pk_bf16_f32 %0, %1, %2" : "=v"(r) : "v"(lo), "v"(hi)); return r; }
__device__ __forceinline__ float bf_lo(unsigned w) { return __uint_as_float(w << 16); }
__device__ __forceinline__ float bf_hi(unsigned w) { return __uint_as_float(w & 0xffff0000u); }

struct EpiStore {
    static constexpr bool PERM = true;
    bf16_t* O; int ldc;
    __device__ __forceinline__ void operator()(const f32x4 (&acc)[2][2][4][2], const Unit& u, int wr, int wc, int fr, int fq) const {
        asm volatile("" : "+v"(fr), "+v"(fq));
        const int row0 = u.pm * BM + wr * 64 + fr, col0 = u.pn * BM + wc * 32 + 8 * fq;
#pragma unroll
        for (int ai = 0; ai < 2; ++ai)
#pragma unroll
            for (int m = 0; m < 4; ++m) { bf16_t* rowp = O + (size_t)(row0 + ai * HALF + m * 16) * ldc + col0;
#pragma unroll
                for (int bj = 0; bj < 2; ++bj) { const f32x4 v0 = acc[ai][bj][m][0], v1 = acc[ai][bj][m][1];
                    u32x4 w; w.x = cvt_pk_bf16(v0[0], v0[1]); w.y = cvt_pk_bf16(v0[2], v0[3]); w.z = cvt_pk_bf16(v1[0], v1[1]); w.w = cvt_pk_bf16(v1[2], v1[3]);
                    *(u32x4*)(rowp + bj * HALF) = w; } }
    }
};
__device__ __forceinline__ float sigmoidf_fast(float a) { return __builtin_amdgcn_rcpf(1.0f + __builtin_amdgcn_exp2f(-1.4426950408889634f * a)); }
struct EpiGlu {
    static constexpr bool PERM = true;
    const bf16_t* Y; bf16_t* Z; float* part;
    __device__ __forceinline__ void operator()(const f32x4 (&acc)[2][2][4][2], const Unit& u, int wr, int wc, int fr, int fq) const {
        asm volatile("" : "+v"(fr), "+v"(fq));
        const int row0 = u.pm * BM + wr * 64 + fr, col0 = u.pn * BM + wc * 32 + 8 * fq;
#pragma unroll
        for (int ai = 0; ai < 2; ++ai) {
            u32x4 yy[4][2];
#pragma unroll
            for (int m = 0; m < 4; ++m)
#pragma unroll
                for (int bj = 0; bj < 2; ++bj) yy[m][bj] = *(const u32x4*)(Y + (size_t)(row0 + ai * HALF + m * 16) * 512 + col0 + bj * HALF);
#pragma unroll
            for (int m = 0; m < 4; ++m) { const int row = row0 + ai * HALF + m * 16; float ss = 0.f;
#pragma unroll
                for (int bj = 0; bj < 2; ++bj) { const int col = col0 + bj * HALF;
                    const u32x4 yv = yy[m][bj];
                    const f32x4 a0 = acc[ai][bj][m][0], a1 = acc[ai][bj][m][1];
                    float v[8];
                    v[0] = bf_lo(yv.x) * sigmoidf_fast(a0[0]); v[1] = bf_hi(yv.x) * sigmoidf_fast(a0[1]);
                    v[2] = bf_lo(yv.y) * sigmoidf_fast(a0[2]); v[3] = bf_hi(yv.y) * sigmoidf_fast(a0[3]);
                    v[4] = bf_lo(yv.z) * sigmoidf_fast(a1[0]); v[5] = bf_hi(yv.z) * sigmoidf_fast(a1[1]);
                    v[6] = bf_lo(yv.w) * sigmoidf_fast(a1[2]); v[7] = bf_hi(yv.w) * sigmoidf_fast(a1[3]);
#pragma unroll
                    for (int e = 0; e < 8; ++e) ss += v[e] * v[e];
                    u32x4 w; w.x = cvt_pk_bf16(v[0], v[1]); w.y = cvt_pk_bf16(v[2], v[3]); w.z = cvt_pk_bf16(v[4], v[5]); w.w = cvt_pk_bf16(v[6], v[7]);
                    *(u32x4*)(Z + (size_t)row * 1024 + col) = w; }
                ss += __shfl_xor(ss, 16); ss += __shfl_xor(ss, 32);
                if (fq == 0) part[(size_t)row * 8 + u.pn * 4 + wc] = ss; }
            asm volatile("" ::: "memory");
        }
    }
};
template <bool BASE16> struct EpiRes {
    static constexpr bool PERM = false;
    const float* base; const bf16_t* base16; float* out; bf16_t* xb; float* part;
    __device__ __forceinline__ void operator()(const f32x4 (&acc)[2][2][4][2], const Unit& u, int wr, int wc, int fr, int fq) const {
        asm volatile("" : "+v"(fr), "+v"(fq));
        const int row0 = u.pm * BM + wr * 64 + fr, col0 = u.pn * BM + wc * 32 + 4 * fq;
#pragma unroll
        for (int ai = 0; ai < 2; ++ai) {
            f32x4 bv[4][2][2];
#pragma unroll
            for (int m = 0; m < 4; ++m) { const size_t off = (size_t)(row0 + ai * HALF + m * 16) * 1024 + col0;
#pragma unroll
                for (int bj = 0; bj < 2; ++bj)
#pragma unroll
                    for (int n = 0; n < 2; ++n) {
                        if constexpr (BASE16) { const u32x2 w = *(const u32x2*)(base16 + off + bj * HALF + n * 16); bv[m][bj][n] = (f32x4){bf_lo(w.x), bf_hi(w.x), bf_lo(w.y), bf_hi(w.y)}; }
                        else bv[m][bj][n] = *(const f32x4*)(base + off + bj * HALF + n * 16); } }
#pragma unroll
            for (int m = 0; m < 4; ++m) { const int row = row0 + ai * HALF + m * 16; float ss = 0.f; const size_t off = (size_t)row * 1024 + col0;
#pragma unroll
                for (int bj = 0; bj < 2; ++bj)
#pragma unroll
                    for (int n = 0; n < 2; ++n) { const size_t o2 = off + bj * HALF + n * 16;
                        const f32x4 v = bv[m][bj][n] + acc[ai][bj][m][n];
                        ss += (v[0] * v[0] + v[1] * v[1]) + (v[2] * v[2] + v[3] * v[3]);
                        if constexpr (BASE16) *(f32x4*)(out + o2) = v;
                        else { u32x2 w; w.x = cvt_pk_bf16(v[0], v[1]); w.y = cvt_pk_bf16(v[2], v[3]); *(u32x2*)(xb + o2) = w; } }
                ss += __shfl_xor(ss, 16); ss += __shfl_xor(ss, 32);
                if (fq == 0) part[(size_t)row * 16 + u.pn * 4 + wc] = ss; }
            asm volatile("" ::: "memory");
        }
    }
};
struct EpiGateUp {
    static constexpr bool PERM = true;
    bf16_t* H; const float* part; float eps;
    __device__ __forceinline__ void operator()(const f32x4 (&acc)[2][2][4][2], const Unit& u, int wr, int wc, int fr, int fq) const {
        asm volatile("" : "+v"(fr), "+v"(fq));
        const int row0 = u.pm * BM + wr * 64 + fr, col0 = u.pn * HALF + wc * 32 + 8 * fq;
#pragma unroll
        for (int ai = 0; ai < 2; ++ai) {
            f32x4 pv[4][4];
#pragma unroll
            for (int m = 0; m < 4; ++m) { const f32x4* pp = (const f32x4*)(part + (size_t)(row0 + ai * HALF + m * 16) * 16);
#pragma unroll
                for (int e = 0; e < 4; ++e) pv[m][e] = pp[e]; }
#pragma unroll
            for (int m = 0; m < 4; ++m) { const int row = row0 + ai * HALF + m * 16;
                const f32x4 p0 = pv[m][0], p1 = pv[m][1], p2 = pv[m][2], p3 = pv[m][3];
                const float s = ((p0[0] + p0[1]) + (p0[2] + p0[3])) + ((p1[0] + p1[1]) + (p1[2] + p1[3])) + ((p2[0] + p2[1]) + (p2[2] + p2[3])) + ((p3[0] + p3[1]) + (p3[2] + p3[3]));
                const float rs = 1.0f / sqrtf(s * (1.0f / 1024.0f) + eps);
                float v[8];
#pragma unroll
                for (int n = 0; n < 2; ++n)
#pragma unroll
                    for (int e = 0; e < 4; ++e) { const float g = acc[ai][0][m][n][e] * rs, up = acc[ai][1][m][n][e] * rs; v[n * 4 + e] = g * sigmoidf_fast(g) * up; }
                u32x4 w; w.x = cvt_pk_bf16(v[0], v[1]); w.y = cvt_pk_bf16(v[2], v[3]); w.z = cvt_pk_bf16(v[4], v[5]); w.w = cvt_pk_bf16(v[6], v[7]);
                *(u32x4*)(H + (size_t)row * 2816 + col0) = w; }
            asm volatile("" ::: "memory");
        }
    }
};

template <class Epi, class Sched, bool ALIGN_EPI, bool SP2, bool MID>
__device__ __forceinline__ void gemm_phase(PG8_LAS unsigned char* lds, const Gemm g, const Sched& S, const Epi& E, const float* midp, float mid_eps) {
    int tid = threadIdx.x; asm volatile("" : "+v"(tid));
    const int wid = __builtin_amdgcn_readfirstlane(tid >> 6), lane = tid & 63, wr = wid >> 2, wc = wid & 3, fr = lane & 15, fq = lane >> 4;
    const int K = g.K, nt = K / BK;
    unsigned voffA[2], voffB[2];
#pragma unroll
    for (int i = 0; i < 2; ++i) { int R, C; stage_rc(tid * 16 + i * 8192, R, C); const int Rb = Epi::PERM ? ((R & ~31) + perm32(R & 31)) : R;
        voffA[i] = (unsigned)(R * K + C) * 2u; voffB[i] = (unsigned)(Rb * K + C) * 2u; }
    const size_t kstep = (size_t)(BK * 2);
    const size_t hstep = (size_t)HALF * K * 2;
    const size_t tstep = 2 * hstep;
    const unsigned ldsw = (unsigned)wid * 1024u;
    const int aoff = lds_byte(wr * 64 + fr, fq * 8), boff = lds_byte(wc * 32 + fr, fq * 8);
#define PG8_SA(b, h) (((b) * 2 + (h)) * HTB)
#define PG8_SB(b, h) ((4 + (b) * 2 + (h)) * HTB)
#define PG8_STAGE(bufoff, gbase, voff) do { _Pragma("unroll") for (int _i = 0; _i < 2; ++_i) \
        __builtin_amdgcn_global_load_lds((const unsigned*)((const char*)(gbase) + (voff)[_i]), (PG8_LAS unsigned*)(lds + (bufoff) + ldsw + _i * 8192), 16, 0, 0); } while (0)
#define PG8_LDA(dst, b, h) do { _Pragma("unroll") for (int m = 0; m < 4; ++m) _Pragma("unroll") for (int k = 0; k < 2; ++k) dst[m][k] = *(const PG8_LAS bf16x8*)(lds + PG8_SA(b, h) + aoff + m * 2048 + k * 1024); } while (0)
#define PG8_LDB(dst, b, h) do { _Pragma("unroll") for (int n = 0; n < 2; ++n) _Pragma("unroll") for (int k = 0; k < 2; ++k) dst[n][k] = *(const PG8_LAS bf16x8*)(lds + PG8_SB(b, h) + boff + n * 2048 + k * 1024); } while (0)
#define PG8_MMA(ai, bj, At, Bt) do { __builtin_amdgcn_s_setprio(1); _Pragma("unroll") for (int m = 0; m < 4; ++m) _Pragma("unroll") for (int n = 0; n < 2; ++n) _Pragma("unroll") for (int k = 0; k < 2; ++k) \
        acc[ai][bj][m][n] = __builtin_amdgcn_mfma_f32_16x16x32_bf16(Bt[n][k], At[m][k], acc[ai][bj][m][n], 0, 0, 0); __builtin_amdgcn_s_setprio(0); } while (0)
#define PG8_WAIT_V(n) asm volatile("s_waitcnt vmcnt(" #n ")" ::: "memory")
#define PG8_WAIT_L(n) asm volatile("s_waitcnt lgkmcnt(" #n ")" ::: "memory")
#define PG8_BAR __builtin_amdgcn_s_barrier()
#define PG8_SCHED __builtin_amdgcn_sched_barrier(0)
    Unit cur, nxt; int ui = 0;
    if (!S.next(0, cur)) return;
    f32x4 acc[2][2][4][2];
#pragma unroll
    for (int a = 0; a < 2; ++a)
#pragma unroll
        for (int b = 0; b < 2; ++b)
#pragma unroll
            for (int m = 0; m < 4; ++m)
#pragma unroll
                for (int n = 0; n < 2; ++n) acc[a][b][m][n] = (f32x4){0.f, 0.f, 0.f, 0.f};
    bf16x8 At[4][2], B0[2][2], B1[2][2];
    const char* cA = (const char*)g.A + (size_t)cur.pm * tstep; const char* cB = (const char*)g.Bt + (size_t)cur.pn * tstep;
    if constexpr (SP2) {
        PG8_STAGE(PG8_SB(0, 0), cB, voffB); PG8_STAGE(PG8_SB(0, 1), cB + hstep, voffB); PG8_STAGE(PG8_SA(0, 0), cA, voffA); PG8_STAGE(PG8_SA(0, 1), cA + hstep, voffA);
        if (wr == 1) PG8_BAR;
        PG8_WAIT_V(2); PG8_BAR;
        PG8_STAGE(PG8_SB(1, 0), cB + kstep, voffB); PG8_STAGE(PG8_SA(1, 0), cA + kstep, voffA); PG8_STAGE(PG8_SB(1, 1), cB + hstep + kstep, voffB);
        PG8_WAIT_V(6); PG8_BAR;
    } else {
        PG8_STAGE(PG8_SB(0, 0), cB, voffB); PG8_STAGE(PG8_SA(0, 0), cA, voffA); PG8_STAGE(PG8_SB(0, 1), cB + hstep, voffB); PG8_STAGE(PG8_SA(0, 1), cA + hstep, voffA);
        if (wr == 1) PG8_BAR;
        PG8_WAIT_V(4); PG8_BAR;
        PG8_STAGE(PG8_SB(1, 0), cB + kstep, voffB); PG8_STAGE(PG8_SA(1, 0), cA + kstep, voffA); PG8_STAGE(PG8_SB(1, 1), cB + hstep + kstep, voffB);
        PG8_WAIT_V(6); PG8_BAR;
    }
    for (;;) {
        const bool has_next = S.next(ui + 1, nxt);
        const char* nA = has_next ? (const char*)g.A + (size_t)nxt.pm * tstep : cA; const char* nB = has_next ? (const char*)g.Bt + (size_t)nxt.pn * tstep : cB;
        for (int t = 0; t < nt; t += 2) {
            const bool last = (t == nt - 2);
            const char* a1 = cA + (size_t)(t + 1) * kstep;
            const char* a2 = last ? nA : cA + (size_t)(t + 2) * kstep; const char* b2 = last ? nB : cB + (size_t)(t + 2) * kstep;
            const char* a3 = a2 + kstep; const char* b3 = b2 + kstep;
            if constexpr (MID) {
                if (t == (nt >> 1)) {
                    PG8_SCHED;
                    f32x4 mp[2][4][2];
#pragma unroll
                    for (int ai = 0; ai < 2; ++ai)
#pragma unroll
                        for (int m = 0; m < 4; ++m) { const int row = cur.pm * BM + ai * HALF + wr * 64 + m * 16 + fr;
                            mp[ai][m][0] = *(const f32x4*)(midp + (size_t)row * 8); mp[ai][m][1] = *(const f32x4*)(midp + (size_t)row * 8 + 4); }
#pragma unroll
                    for (int ai = 0; ai < 2; ++ai)
#pragma unroll
                        for (int m = 0; m < 4; ++m) { const f32x4 p0 = mp[ai][m][0], p1 = mp[ai][m][1];
                            const float s = ((p0[0] + p0[1]) + (p0[2] + p0[3])) + ((p1[0] + p1[1]) + (p1[2] + p1[3]));
                            const float rs = 1.0f / sqrtf(s * (1.0f / 512.0f) + mid_eps);
#pragma unroll
                            for (int bj = 0; bj < 2; ++bj)
#pragma unroll
                                for (int n = 0; n < 2; ++n) acc[ai][bj][m][n] = acc[ai][bj][m][n] * rs; }
                    PG8_WAIT_V(0);
                    PG8_SCHED;
                }
            }
            if constexpr (SP2) {
            PG8_LDB(B0, 0, 0); PG8_LDB(B1, 0, 1); PG8_SCHED; PG8_LDA(At, 0, 0); PG8_STAGE(PG8_SA(1, 1), a1 + hstep, voffA);
            PG8_WAIT_V(8); PG8_WAIT_L(0); PG8_BAR; PG8_MMA(0, 0, At, B0); PG8_MMA(0, 1, At, B1); PG8_BAR; PG8_SCHED;
            PG8_LDA(At, 0, 1); PG8_STAGE(PG8_SB(0, 0), b2, voffB); PG8_STAGE(PG8_SB(0, 1), b2 + hstep, voffB); PG8_STAGE(PG8_SA(0, 0), a2, voffA);
            PG8_WAIT_V(8); PG8_WAIT_L(0); PG8_BAR; PG8_MMA(1, 0, At, B0); PG8_MMA(1, 1, At, B1); PG8_BAR; PG8_SCHED;
            PG8_LDB(B0, 1, 0); PG8_LDB(B1, 1, 1); PG8_SCHED; PG8_LDA(At, 1, 0); PG8_STAGE(PG8_SA(0, 1), a2 + hstep, voffA);
            PG8_WAIT_V(8); PG8_WAIT_L(0); PG8_BAR; PG8_MMA(0, 0, At, B0); PG8_MMA(0, 1, At, B1); PG8_BAR; PG8_SCHED;
            PG8_LDA(At, 1, 1); PG8_STAGE(PG8_SB(1, 0), b3, voffB); PG8_STAGE(PG8_SB(1, 1), b3 + hstep, voffB); PG8_STAGE(PG8_SA(1, 0), a3, voffA);
            PG8_WAIT_V(8); PG8_WAIT_L(0); PG8_BAR; PG8_MMA(1, 0, At, B0); PG8_MMA(1, 1, At, B1); PG8_BAR; PG8_SCHED;
            } else {
            PG8_LDB(B0, 0, 0); PG8_SCHED; PG8_LDA(At, 0, 0); PG8_STAGE(PG8_SA(1, 1), a1 + hstep, voffA);
            PG8_WAIT_L(8); PG8_BAR; PG8_WAIT_L(0); PG8_MMA(0, 0, At, B0); PG8_BAR; PG8_SCHED;
            PG8_LDB(B1, 0, 1); PG8_STAGE(PG8_SB(0, 0), b2, voffB);
            PG8_BAR; PG8_WAIT_L(0); PG8_MMA(0, 1, At, B1); PG8_BAR;
            PG8_LDA(At, 0, 1); PG8_STAGE(PG8_SA(0, 0), a2, voffA);
            PG8_BAR; PG8_WAIT_L(0); PG8_MMA(1, 0, At, B0); PG8_BAR; PG8_SCHED;
            PG8_STAGE(PG8_SB(0, 1), b2 + hstep, voffB);
            PG8_WAIT_V(6); PG8_BAR; PG8_MMA(1, 1, At, B1); PG8_BAR;
            PG8_LDB(B0, 1, 0); PG8_SCHED; PG8_LDA(At, 1, 0); PG8_STAGE(PG8_SA(0, 1), a2 + hstep, voffA);
            PG8_WAIT_L(8); PG8_BAR; PG8_WAIT_L(0); PG8_MMA(0, 0, At, B0); PG8_BAR; PG8_SCHED;
            PG8_LDB(B1, 1, 1); PG8_STAGE(PG8_SB(1, 0), b3, voffB);
            PG8_BAR; PG8_WAIT_L(0); PG8_MMA(0, 1, At, B1); PG8_BAR;
            PG8_LDA(At, 1, 1); PG8_STAGE(PG8_SA(1, 0), a3, voffA);
            PG8_BAR; PG8_WAIT_L(0); PG8_MMA(1, 0, At, B0); PG8_BAR; PG8_SCHED;
            PG8_STAGE(PG8_SB(1, 1), b3 + hstep, voffB);
            PG8_WAIT_V(6); PG8_BAR; PG8_MMA(1, 1, At, B1); PG8_BAR;
            }
        }
        if constexpr (ALIGN_EPI) { if (wr == 0) PG8_BAR; }
        E(acc, cur, wr, wc, fr, fq);
        if (!has_next) break;
#pragma unroll
        for (int a = 0; a < 2; ++a)
#pragma unroll
            for (int b = 0; b < 2; ++b)
#pragma unroll
                for (int m = 0; m < 4; ++m)
#pragma unroll
                    for (int n = 0; n < 2; ++n) acc[a][b][m][n] = (f32x4){0.f, 0.f, 0.f, 0.f};
        cur = nxt; cA = nA; cB = nB; ++ui;
        if constexpr (ALIGN_EPI) { if (wr == 1) PG8_BAR; }
    }
    PG8_WAIT_V(0);
    if constexpr (!ALIGN_EPI) { if (wr == 0) PG8_BAR; }
    PG8_BAR;
#undef PG8_SA
#undef PG8_SB
#undef PG8_STAGE
#undef PG8_LDA
#undef PG8_LDB
#undef PG8_MMA
#undef PG8_WAIT_V
#undef PG8_WAIT_L
#undef PG8_BAR
#undef PG8_SCHED
}
}

using pg8::bf16_t; using pg8::bf16x8; using pg8::f32x4; using pg8::u32x4; using pg8::u32x2; using pg8::cvt_pk_bf16;
typedef float f32x16 __attribute__((ext_vector_type(16)));
typedef short s16x4 __attribute__((ext_vector_type(4)));
constexpr int NB = 8, SEQ = 4096, DM = 1024, MTOK = NB * SEQ;
constexpr int NHEAD = 8, HD = 64, DATT = 512, DSSM = 512, NGRP = 32, GCH = 16, NST = 64, DFF = 2816;
constexpr int PROJ_LD = 1536;
constexpr int VT_LD = 32768 + 64;
constexpr float EPS = 1e-6f;
constexpr int NWAVES = 8, NTHR = 512;
constexpr int LDS_BYTES = 147456;
constexpr float ATT_SC = 0.125f * 1.4426950408889634f;
constexpr int MISC_OFF = 147456 - 512;

constexpr size_t MiB = 1u << 20;
constexpr size_t WS_CTL = 0, CTL_ZERO_BYTES = 65536;
constexpr int CW_BAR = 4096;
constexpr size_t WS_WIN = 1 * MiB;
constexpr size_t WS_WGLU = 5 * MiB;
constexpr size_t WS_WOUT = 6 * MiB;
constexpr size_t WS_WGU = 8 * MiB;
constexpr size_t WS_WDN = 20 * MiB;
constexpr size_t WS_SSM = 26 * MiB;
constexpr size_t WS_LAM16 = 34 * MiB;
constexpr size_t WS_PART1 = 35 * MiB;
constexpr size_t WS_PART2 = 36 * MiB;
constexpr size_t WS_PART3 = 38 * MiB;
constexpr size_t WS_XN = 48 * MiB;
constexpr size_t WS_Z = 112 * MiB;
constexpr size_t WS_VT = 176 * MiB;
constexpr size_t WS_PROJ = 210 * MiB;
constexpr size_t WS_YG = 306 * MiB;
constexpr size_t WS_H = 176 * MiB;
constexpr size_t WS_END = 352 * MiB;

__device__ __forceinline__ int crow(int r, int hi) { return (r & 3) + 8 * (r >> 2) + 4 * hi; }
__device__ __forceinline__ float2 cmul(float2 a, float2 b) { return make_float2(a.x * b.x - a.y * b.y, a.x * b.y + a.y * b.x); }
__device__ __forceinline__ unsigned short bf1(float v) { return (unsigned short)(cvt_pk_bf16(v, v) & 0xffffu); }
__device__ __forceinline__ float wave_sum(float v) {
#pragma unroll
    for (int o = 1; o < 64; o <<= 1) v += __shfl_xor(v, o);
    return v;
}

struct Args {
    const float* x; const float* norm1_g; const float* w_in; const float* attn_norm_g; const float* lambda_re; const float* lambda_im; const float* log_step;
    const float* b_re; const float* b_im; const float* c_re; const float* c_im; const float* d_skip; const float* w_glu; const float* ssm_norm_g; const float* w_out;
    const float* norm2_g; const float* w_gate; const float* w_up; const float* w_down; const float* final_norm_g;
    float* out; unsigned char* ws;
};

__device__ __forceinline__ void transpose_item(const float* W, int N, bf16_t* WT, int ldt, int k0, int n0, int drow0, int dcol0, const float* gk, float* scr, int lane, float mul = 1.0f) {
    f32x4 v[8];
    const int rk = lane >> 3, c4 = (lane & 7) * 4;
#pragma unroll
    for (int i = 0; i < 8; ++i) v[i] = *(const f32x4*)(W + (size_t)(k0 + 8 * i + rk) * N + n0 + c4);
#pragma unroll
    for (int i = 0; i < 8; ++i) { const int kk = 8 * i + rk; const float m2 = gk ? mul * gk[k0 + kk] : mul;
        scr[kk * 33 + c4 + 0] = v[i][0] * m2; scr[kk * 33 + c4 + 1] = v[i][1] * m2; scr[kk * 33 + c4 + 2] = v[i][2] * m2; scr[kk * 33 + c4 + 3] = v[i][3] * m2; }
    asm volatile("s_waitcnt lgkmcnt(0)" ::: "memory");
    const int c = lane & 7;
#pragma unroll
    for (int j = 0; j < 4; ++j) { const int n = (lane >> 3) + 8 * j; const float* s = scr + (8 * c) * 33 + n;
        u32x4 o; o.x = cvt_pk_bf16(s[0 * 33], s[1 * 33]); o.y = cvt_pk_bf16(s[2 * 33], s[3 * 33]); o.z = cvt_pk_bf16(s[4 * 33], s[5 * 33]); o.w = cvt_pk_bf16(s[6 * 33], s[7 * 33]);
        *(u32x4*)(WT + (size_t)(drow0 + n) * ldt + dcol0 + 8 * c) = o; }
    asm volatile("s_waitcnt lgkmcnt(0)" ::: "memory");
}

__device__ __forceinline__ void ssm_mats(const Args& A, int g, int part, char* lds) {
    float2* lamp = (float2*)lds;
    float2* bbm = lamp + 17 * 64;
    float2* cm = bbm + 1024;
    float* Kt = (float*)(cm + 1024);
    float2* fb = (float2*)(Kt + 512);
    const int tid = threadIdx.x;
    bf16_t* WstT = (bf16_t*)(A.ws + WS_SSM + (size_t)g * 262144); bf16_t* KinT = WstT + 128 * 256; bf16_t* WinT = KinT + 256 * 256;
    if (tid < 64) { const int p = tid; const float lr = A.lambda_re[g * 64 + p], li = A.lambda_im[g * 64 + p]; const float dt = expf(A.log_step[g]);
        const float mag = expf(lr * dt), ang = li * dt; const float lbr = mag * cosf(ang), lbi = mag * sinf(ang);
        const float den = lr * lr + li * li, nr = lbr - 1.0f; fb[p] = make_float2((nr * lr + lbi * li) / den, (lbi * lr - nr * li) / den);
        float2 pw = make_float2(1.f, 0.f); const float2 lb = make_float2(lbr, lbi);
        for (int k = 0; k <= 16; ++k) { lamp[k * 64 + p] = pw; pw = cmul(pw, lb); }
        if (part == 0) ((float2*)(A.ws + WS_LAM16))[g * 64 + p] = lamp[16 * 64 + p]; }
    __syncthreads();
    for (int idx = tid; idx < 1024; idx += NTHR) { { const int p = idx >> 4, h = idx & 15; const float br = A.b_re[(size_t)(g * 64 + p) * 16 + h], bi = A.b_im[(size_t)(g * 64 + p) * 16 + h]; const float2 f = fb[p];
            bbm[idx] = make_float2(f.x * br - f.y * bi, f.x * bi + f.y * br); }
        { const int h = idx >> 6, p = idx & 63; cm[idx] = make_float2(A.c_re[(size_t)(g * 16 + h) * 64 + p], A.c_im[(size_t)(g * 16 + h) * 64 + p]); } }
    __syncthreads();
    { const int idx = tid, tau = 2 * part + (idx >> 8), h = (idx >> 4) & 15, hp = idx & 15; float s = 0.f;
        for (int p = 0; p < 64; ++p) { const float2 cl = cmul(cm[h * 64 + p], lamp[tau * 64 + p]); const float2 bq = bbm[p * 16 + hp]; s += cl.x * bq.x - cl.y * bq.y; }
        if (tau == 0 && h == hp) s += A.d_skip[g * 16 + h];
        Kt[idx] = s; }
    __syncthreads();
    for (int ch = tid; ch < 1024; ch += NTHR) { const int tl = ch >> 9, rem = ch & 511, t = rem >> 5, h = (rem >> 1) & 15, half = rem & 1, tau = 2 * part + tl, sx = t - tau;
        if (sx >= 0) { const float* kp = Kt + (tl * 16 + h) * 16 + half * 8;
            u32x4 o; o.x = cvt_pk_bf16(kp[0], kp[1]); o.y = cvt_pk_bf16(kp[2], kp[3]); o.z = cvt_pk_bf16(kp[4], kp[5]); o.w = cvt_pk_bf16(kp[6], kp[7]);
            *(u32x4*)(KinT + (size_t)(t * 16 + h) * 256 + sx * 16 + half * 8) = o; } }
    for (int ch = tid; ch < 1024; ch += NTHR) { const int tl = ch >> 9, rem = ch & 511, sx = rem >> 5, h = (rem >> 1) & 15, half = rem & 1, t = 2 * part + tl;
        if (sx > t) *(u32x4*)(KinT + (size_t)(t * 16 + h) * 256 + sx * 16 + half * 8) = (u32x4){0u, 0u, 0u, 0u}; }
    { const int ch = tid, n = 16 * part + (ch >> 5), kc = ch & 31, nb = n >> 5, j = n & 31, p = 32 * (nb >> 1) + j, pt = nb & 1, sx = kc >> 1, hp0 = (kc & 1) * 8; float v[8];
        const float2 l = lamp[(15 - sx) * 64 + p];
#pragma unroll
        for (int e = 0; e < 8; ++e) { const float2 w = cmul(l, bbm[p * 16 + hp0 + e]); v[e] = pt ? w.y : w.x; }
        u32x4 o; o.x = cvt_pk_bf16(v[0], v[1]); o.y = cvt_pk_bf16(v[2], v[3]); o.z = cvt_pk_bf16(v[4], v[5]); o.w = cvt_pk_bf16(v[6], v[7]);
        *(u32x4*)(WstT + (size_t)n * 256 + kc * 8) = o; }
    { const int ch = tid, n = 32 * part + (ch >> 4), kc = ch & 15, t = n >> 4, h = n & 15; float v[8];
#pragma unroll
        for (int e = 0; e < 8; ++e) { const int k2 = kc * 8 + e, nb2 = k2 >> 5, j2 = k2 & 31, p = 32 * (nb2 >> 1) + j2, pt = nb2 & 1;
            const float2 w = cmul(cm[h * 64 + p], lamp[(t + 1) * 64 + p]); v[e] = pt ? -w.y : w.x; }
        u32x4 o; o.x = cvt_pk_bf16(v[0], v[1]); o.y = cvt_pk_bf16(v[2], v[3]); o.z = cvt_pk_bf16(v[4], v[5]); o.w = cvt_pk_bf16(v[6], v[7]);
        *(u32x4*)(WinT + (size_t)n * 128 + kc * 8) = o; }
    __syncthreads();
}

__device__ __forceinline__ void p0_prologue(const Args& A, char* lds, int G) {
    const int tid = threadIdx.x, lane = tid & 63, wave = tid >> 6;
    const int bx = blockIdx.x;
    for (int u = bx; u < NGRP * 8; u += G) ssm_mats(A, u >> 3, u & 7, lds);
    float* scr = (float*)(lds + wave * 16384);
    const int gw = bx * NWAVES + wave, NGW = G * NWAVES;
    bf16_t* Win_t = (bf16_t*)(A.ws + WS_WIN); bf16_t* Wglu_t = (bf16_t*)(A.ws + WS_WGLU); bf16_t* Wout_t = (bf16_t*)(A.ws + WS_WOUT);
    bf16_t* Wgu_t = (bf16_t*)(A.ws + WS_WGU); bf16_t* Wdn_t = (bf16_t*)(A.ws + WS_WDN);
    constexpr int I_IN = 16 * 64, I_GLU = 8 * 16, I_OUT = 16 * 32, I_G = 16 * 88, I_U = 16 * 88, I_D = 44 * 32;
    constexpr int NITEMS = I_IN + I_GLU + I_OUT + I_G + I_U + I_D;
    for (int it = gw; it < NITEMS; it += NGW) {
        int r = it;
        if (r < I_IN) { const int kb = r / 64, nb = r % 64, n0 = 32 * nb; const int drow0 = (n0 < 1024) ? n0 : (n0 < 1536 ? n0 + 512 : n0 - 512);
            transpose_item(A.w_in, 2048, Win_t, 1024, 64 * kb, n0, drow0, 64 * kb, nullptr, scr, lane, n0 < 512 ? ATT_SC : 1.0f); continue; } r -= I_IN;
        if (r < I_GLU) { const int kb = r / 16, nb = r % 16; transpose_item(A.w_glu, 512, Wglu_t, 512, 64 * kb, 32 * nb, 32 * nb, 64 * kb, nullptr, scr, lane); continue; } r -= I_GLU;
        if (r < I_OUT) { const int kb = r / 32, nb = r % 32, k0 = 64 * kb; const bool ssm = k0 >= 512;
            transpose_item(A.w_out, 1024, Wout_t, 1024, k0, 32 * nb, 32 * nb, ssm ? k0 - 512 : k0 + 512, ssm ? (A.ssm_norm_g - 512) : A.attn_norm_g, scr, lane); continue; } r -= I_OUT;
        if (r < I_G) { const int kb = r / 88, nb = r % 88, n0 = 32 * nb; transpose_item(A.w_gate, DFF, Wgu_t, 1024, 64 * kb, n0, 256 * (n0 / 128) + (n0 % 128), 64 * kb, A.norm2_g, scr, lane); continue; } r -= I_G;
        if (r < I_U) { const int kb = r / 88, nb = r % 88, n0 = 32 * nb; transpose_item(A.w_up, DFF, Wgu_t, 1024, 64 * kb, n0, 256 * (n0 / 128) + 128 + (n0 % 128), 64 * kb, A.norm2_g, scr, lane); continue; } r -= I_U;
        { const int kb = r / 32, nb = r % 32; transpose_item(A.w_down, 1024, Wdn_t, DFF, 64 * kb, 32 * nb, 32 * nb, 64 * kb, nullptr, scr, lane); }
    }
    bf16_t* XN = (bf16_t*)(A.ws + WS_XN);
    f32x4 gv[4];
#pragma unroll
    for (int j = 0; j < 4; ++j) gv[j] = ((const f32x4*)A.norm1_g)[lane + 64 * j];
    const int nskip = 0;
    if (bx >= nskip) {
        const int gw2 = (bx - nskip) * NWAVES + wave, NGW2 = (G - nskip) * NWAVES;
        for (int m = gw2; m < MTOK; m += 2 * NGW2) {
            const int m1 = m + NGW2; const bool has1 = m1 < MTOK;
            const f32x4* xr0 = (const f32x4*)(A.x + (size_t)m * DM) + lane; const f32x4* xr1 = (const f32x4*)(A.x + (size_t)(has1 ? m1 : m) * DM) + lane;
            f32x4 v0[4], v1[4]; float s0 = 0.f, s1 = 0.f;
#pragma unroll
            for (int j = 0; j < 4; ++j) { v0[j] = xr0[64 * j]; v1[j] = xr1[64 * j]; }
#pragma unroll
            for (int j = 0; j < 4; ++j) { s0 += (v0[j][0] * v0[j][0] + v0[j][1] * v0[j][1]) + (v0[j][2] * v0[j][2] + v0[j][3] * v0[j][3]); s1 += (v1[j][0] * v1[j][0] + v1[j][1] * v1[j][1]) + (v1[j][2] * v1[j][2] + v1[j][3] * v1[j][3]); }
            const float rs0 = 1.0f / sqrtf(wave_sum(s0) * (1.0f / DM) + EPS), rs1 = 1.0f / sqrtf(wave_sum(s1) * (1.0f / DM) + EPS);
            u32x2* o0 = (u32x2*)(XN + (size_t)m * DM) + lane;
#pragma unroll
            for (int j = 0; j < 4; ++j) { u32x2 w; w.x = cvt_pk_bf16(v0[j][0] * rs0 * gv[j][0], v0[j][1] * rs0 * gv[j][1]); w.y = cvt_pk_bf16(v0[j][2] * rs0 * gv[j][2], v0[j][3] * rs0 * gv[j][3]); o0[64 * j] = w; }
            if (has1) { u32x2* o1 = (u32x2*)(XN + (size_t)m1 * DM) + lane;
#pragma unroll
                for (int j = 0; j < 4; ++j) { u32x2 w; w.x = cvt_pk_bf16(v1[j][0] * rs1 * gv[j][0], v1[j][1] * rs1 * gv[j][1]); w.y = cvt_pk_bf16(v1[j][2] * rs1 * gv[j][2], v1[j][3] * rs1 * gv[j][3]); o1[64 * j] = w; } }
        }
    }
}

__device__ __forceinline__ float gelu_tanh(float y) {
    const float u = 0.7978845608028654f * (y + 0.044715f * y * y * y);
    return y * __builtin_amdgcn_rcpf(1.0f + __builtin_amdgcn_exp2f(-2.0f * 1.4426950408889634f * u));
}
template <int NCHUNK_PER_THREAD, int ROWB, int DSTRIDE>
__device__ __forceinline__ void lds_fill(char* dst, const bf16_t* src, int tid) {
    u32x4 v[NCHUNK_PER_THREAD];
#pragma unroll
    for (int i = 0; i < NCHUNK_PER_THREAD; ++i) v[i] = ((const u32x4*)src)[tid + i * NTHR];
#pragma unroll
    for (int i = 0; i < NCHUNK_PER_THREAD; ++i) { const int c = tid + i * NTHR, row = c / (ROWB / 16), col = c % (ROWB / 16); *(u32x4*)(dst + row * DSTRIDE + col * 16) = v[i]; }
}
__device__ __forceinline__ void ssm_item(const Args& A, int b, int g, char* lds) {
    const int tid = threadIdx.x, lane = tid & 63, w = __builtin_amdgcn_readfirstlane(tid >> 6), j = lane & 31, hi = lane >> 5;
    char* R2 = lds;
    float2* E = (float2*)lds;
    bf16_t* XS = (bf16_t*)(lds + 65536);
    float2* SEG = (float2*)(lds + 65536 + 69632);
    const bf16_t* PROJ = (const bf16_t*)(A.ws + WS_PROJ);
    const bf16_t* WstT = (const bf16_t*)(A.ws + WS_SSM + (size_t)g * 262144); const bf16_t* KinT = WstT + 128 * 256; const bf16_t* WinT = KinT + 256 * 256;
    const float2* LAM16 = (const float2*)(A.ws + WS_LAM16);
    bf16_t* YG = (bf16_t*)(A.ws + WS_YG);
    bf16x8 ua[16];
    { const bf16_t* up = PROJ + ((size_t)(b * SEQ + 16 * (32 * w + j))) * PROJ_LD + 1024 + g * 16 + 8 * hi;
#pragma unroll
      for (int tl = 0; tl < 16; ++tl) ua[tl] = *(const bf16x8*)(up + (size_t)tl * PROJ_LD); }
#pragma unroll 1
    for (int hp = 0; hp < 2; ++hp) {
        lds_fill<4, 512, 528>(R2, WstT + (size_t)64 * hp * 256, tid);
        __syncthreads();
        f32x16 are = {}, aim = {};
        const char* bl = R2 + j * 528 + hi * 16;
#pragma unroll
        for (int ks = 0; ks < 16; ++ks) { const bf16x8 br = *(const bf16x8*)(bl + ks * 32), bi = *(const bf16x8*)(bl + 32 * 528 + ks * 32);
            are = __builtin_amdgcn_mfma_f32_32x32x16_bf16(ua[ks], br, are, 0, 0, 0); aim = __builtin_amdgcn_mfma_f32_32x32x16_bf16(ua[ks], bi, aim, 0, 0, 0); }
        __syncthreads();
#pragma unroll
        for (int r = 0; r < 16; ++r) E[(32 * w + crow(r, hi)) * 32 + j] = make_float2(are[r], aim[r]);
        __syncthreads();
        { const int seg = tid >> 5, pl = tid & 31; const float2 l16 = LAM16[g * 64 + 32 * hp + pl];
          float2 x = make_float2(0.f, 0.f);
#pragma unroll
          for (int i = 0; i < 16; ++i) { const float2 e = E[(16 * seg + i) * 32 + pl]; const float2 t = cmul(l16, x); x = make_float2(t.x + e.x, t.y + e.y); }
          SEG[seg * 32 + pl] = x;
          __syncthreads();
          float2 l256 = l16;
#pragma unroll
          for (int q = 0; q < 4; ++q) l256 = cmul(l256, l256);
          float2 xs = make_float2(0.f, 0.f);
          for (int s2 = 0; s2 < seg; ++s2) { const float2 e = SEG[s2 * 32 + pl]; const float2 t = cmul(l256, xs); xs = make_float2(t.x + e.x, t.y + e.y); }
          x = xs;
#pragma unroll
          for (int i = 0; i < 16; ++i) { const int c = 16 * seg + i; XS[c * 136 + 64 * hp + pl] = bf1(x.x); XS[c * 136 + 64 * hp + 32 + pl] = bf1(x.y);
              const float2 e = E[c * 32 + pl]; const float2 t = cmul(l16, x); x = make_float2(t.x + e.x, t.y + e.y); } }
        __syncthreads();
    }
#pragma unroll 1
    for (int qd = 0; qd < 4; ++qd) {
        lds_fill<4, 512, 528>(R2, KinT + (size_t)64 * qd * 256, tid);
        lds_fill<2, 256, 272>(R2 + 33792, WinT + (size_t)64 * qd * 128, tid);
        __syncthreads();
        f32x16 acc[2]; acc[0] = f32x16{}; acc[1] = f32x16{};
        const char* kl = R2 + j * 528 + hi * 16;
#pragma unroll
        for (int ks = 0; ks < 16; ++ks)
#pragma unroll
            for (int q = 0; q < 2; ++q) { if (ks <= 2 * (2 * qd + q) + 1) {
                    const bf16x8 bv = *(const bf16x8*)(kl + q * 32 * 528 + ks * 32); acc[q] = __builtin_amdgcn_mfma_f32_32x32x16_bf16(ua[ks], bv, acc[q], 0, 0, 0); } }
        const char* wl = R2 + 33792 + j * 272 + hi * 16;
#pragma unroll
        for (int k2 = 0; k2 < 8; ++k2) { const bf16x8 av = *(const bf16x8*)(XS + (32 * w + j) * 136 + 16 * k2 + 8 * hi);
#pragma unroll
            for (int q = 0; q < 2; ++q) { const bf16x8 bv = *(const bf16x8*)(wl + q * 32 * 272 + k2 * 32); acc[q] = __builtin_amdgcn_mfma_f32_32x32x16_bf16(av, bv, acc[q], 0, 0, 0); } }
#pragma unroll
        for (int q = 0; q < 2; ++q) { const int n = 64 * qd + 32 * q + j, t = n >> 4, h = n & 15;
#pragma unroll
            for (int r = 0; r < 16; ++r) { const int c = 32 * w + crow(r, hi); const int tok = 16 * c + t;
                YG[(size_t)(b * SEQ + tok) * DSSM + g * 16 + h] = bf1(gelu_tanh(acc[q][r])); } }
        __syncthreads();
    }
}

constexpr float ATT_STOP = 127.0f;
struct KVTile { u32x4 k[4], v[4]; };
constexpr int KST = 144, VST = 80, KV_STAGE = 32 * KST + 64 * VST;
__device__ __forceinline__ void kv_load(KVTile& t, const bf16_t* kraw, const bf16_t* vraw, int kt) {
#pragma unroll
    for (int i = 0; i < 4; ++i) t.k[i] = *(const u32x4*)(kraw + (size_t)(32 * kt + 8 * i) * PROJ_LD);
#pragma unroll
    for (int i = 0; i < 4; ++i) t.v[i] = *(const u32x4*)(vraw + (size_t)(16 * i) * VT_LD + 32 * kt);
}
template <bool DIAG>
__device__ __forceinline__ void attn_tile(const KVTile& t, char* stage, const bf16x8 (&qf)[4], f32x16& o0, f32x16& o1, float& R2, int lane, int j, int hi) {
    char* KS = stage; char* VS = stage + 32 * KST;
#pragma unroll
    for (int i = 0; i < 4; ++i) *(u32x4*)(KS + (8 * i + (lane >> 3)) * KST + (lane & 7) * 16) = t.k[i];
#pragma unroll
    for (int i = 0; i < 4; ++i) *(u32x4*)(VS + (16 * i + (lane >> 2)) * VST + (lane & 3) * 16) = t.v[i];
    bf16x8 kf[4];
#pragma unroll
    for (int d0 = 0; d0 < 4; ++d0) kf[d0] = *(const bf16x8*)(KS + j * KST + 32 * d0 + 16 * hi);
    bf16x8 vf[2][2];
#pragma unroll
    for (int db = 0; db < 2; ++db)
#pragma unroll
        for (int ks = 0; ks < 2; ++ks) { const char* vp = VS + (32 * db + j) * VST + (16 * ks + 4 * hi) * 2; const s16x4 a = *(const s16x4*)vp, c = *(const s16x4*)(vp + 16);
            vf[db][ks] = (bf16x8){a[0], a[1], a[2], a[3], c[0], c[1], c[2], c[3]}; }
    f32x16 s = {};
#pragma unroll
    for (int d0 = 0; d0 < 4; ++d0) s = __builtin_amdgcn_mfma_f32_32x32x16_bf16(kf[d0], qf[d0], s, 0, 0, 0);
    float rr[16], sg[16];
#pragma unroll
    for (int r = 0; r < 16; ++r) { const float e = __builtin_amdgcn_exp2f(s[r]); rr[r] = __builtin_amdgcn_rcpf(1.0f + e); sg[r] = 1.0f - rr[r];
        if (DIAG) { const bool msk = crow(r, hi) >= j; rr[r] = msk ? 1.0f : rr[r]; sg[r] = msk ? 0.0f : sg[r]; } }
    float gp[4], pg[4];
#pragma unroll
    for (int g4 = 0; g4 < 4; ++g4) { gp[g4] = (rr[4 * g4] * rr[4 * g4 + 1]) * (rr[4 * g4 + 2] * rr[4 * g4 + 3]); pg[g4] = __shfl_xor(gp[g4], 32); }
    float T[4]; T[3] = 1.0f; T[2] = gp[3] * pg[3]; T[1] = T[2] * (gp[2] * pg[2]); T[0] = T[1] * (gp[1] * pg[1]);
    const float tp = T[0] * (gp[0] * pg[0]);
    const float Pr = __builtin_amdgcn_exp2f(-R2);
    float wv[16];
#pragma unroll
    for (int g4 = 0; g4 < 4; ++g4) { const float c3 = T[g4] * (hi == 0 ? pg[g4] : 1.0f) * Pr;
        const float c2 = c3 * rr[4 * g4 + 3], c1 = c2 * rr[4 * g4 + 2], c0 = c1 * rr[4 * g4 + 1];
        wv[4 * g4 + 3] = sg[4 * g4 + 3] * c3; wv[4 * g4 + 2] = sg[4 * g4 + 2] * c2; wv[4 * g4 + 1] = sg[4 * g4 + 1] * c1; wv[4 * g4 + 0] = sg[4 * g4 + 0] * c0; }
    R2 -= __builtin_amdgcn_logf(tp);
    u32x4 p0, p1;
    p0.x = cvt_pk_bf16(wv[0], wv[1]); p0.y = cvt_pk_bf16(wv[2], wv[3]); p0.z = cvt_pk_bf16(wv[4], wv[5]); p0.w = cvt_pk_bf16(wv[6], wv[7]);
    p1.x = cvt_pk_bf16(wv[8], wv[9]); p1.y = cvt_pk_bf16(wv[10], wv[11]); p1.z = cvt_pk_bf16(wv[12], wv[13]); p1.w = cvt_pk_bf16(wv[14], wv[15]);
    const bf16x8 pa0 = __builtin_bit_cast(bf16x8, p0), pa1 = __builtin_bit_cast(bf16x8, p1);
    o0 = __builtin_amdgcn_mfma_f32_32x32x16_bf16(pa0, vf[0][0], o0, 0, 0, 0); o0 = __builtin_amdgcn_mfma_f32_32x32x16_bf16(pa1, vf[0][1], o0, 0, 0, 0);
    o1 = __builtin_amdgcn_mfma_f32_32x32x16_bf16(pa0, vf[1][0], o1, 0, 0, 0); o1 = __builtin_amdgcn_mfma_f32_32x32x16_bf16(pa1, vf[1][1], o1, 0, 0, 0);
}
__device__ __forceinline__ void attn_item(const Args& A, int b, int qt, char* lds) {
    const int tid = threadIdx.x, lane = tid & 63, h = __builtin_amdgcn_readfirstlane(tid >> 6), j = lane & 31, hi = lane >> 5;
    char* stage = lds + h * KV_STAGE;
    float* OST = (float*)stage;
    float* PART = (float*)(lds + 8 * KV_STAGE);
    const bf16_t* PROJ = (const bf16_t*)(A.ws + WS_PROJ);
    const bf16_t* VT = (const bf16_t*)(A.ws + WS_VT);
    bf16_t* Z = (bf16_t*)(A.ws + WS_Z);
    const int q0 = 32 * qt; const size_t rowbase = (size_t)b * SEQ;
    const bf16_t* kraw = PROJ + (rowbase + (lane >> 3)) * PROJ_LD + 512 + h * 64 + (lane & 7) * 8;
    const bf16_t* vraw = VT + (size_t)(h * 64 + (lane >> 2)) * VT_LD + rowbase + (lane & 3) * 8;
    KVTile t0, t1, t2;
    kv_load(t0, kraw, vraw, qt);
    bf16x8 qf[4];
    { const bf16_t* qp = PROJ + (rowbase + q0 + j) * PROJ_LD + h * 64 + 8 * hi;
#pragma unroll
      for (int d0 = 0; d0 < 4; ++d0) qf[d0] = *(const bf16x8*)(qp + 16 * d0); }
    kv_load(t1, kraw, vraw, qt > 1 ? qt - 1 : 0);
    kv_load(t2, kraw, vraw, qt > 2 ? qt - 2 : 0);
    f32x16 o0 = {}, o1 = {}; float R2 = 0.f;
    for (int kt = qt;;) {
        if (kt == qt) attn_tile<true>(t0, stage, qf, o0, o1, R2, lane, j, hi); else attn_tile<false>(t0, stage, qf, o0, o1, R2, lane, j, hi);
        if (kt == 0 || __all(R2 > ATT_STOP)) break; kv_load(t0, kraw, vraw, kt > 3 ? kt - 3 : 0); --kt;
        attn_tile<false>(t1, stage, qf, o0, o1, R2, lane, j, hi);    if (kt == 0 || __all(R2 > ATT_STOP)) break; kv_load(t1, kraw, vraw, kt > 3 ? kt - 3 : 0); --kt;
        attn_tile<false>(t2, stage, qf, o0, o1, R2, lane, j, hi);    if (kt == 0 || __all(R2 > ATT_STOP)) break; kv_load(t2, kraw, vraw, kt > 3 ? kt - 3 : 0); --kt;
    }
#pragma unroll
    for (int r = 0; r < 16; ++r) { OST[crow(r, hi) * 68 + j] = o0[r]; OST[crow(r, hi) * 68 + 32 + j] = o1[r]; }
    asm volatile("s_waitcnt lgkmcnt(0)" ::: "memory");
    f32x4 ov[8]; float ss = 0.f;
#pragma unroll
    for (int e = 0; e < 8; ++e) { ov[e] = *(const f32x4*)(OST + j * 68 + 32 * hi + 4 * e); ss += (ov[e][0] * ov[e][0] + ov[e][1] * ov[e][1]) + (ov[e][2] * ov[e][2] + ov[e][3] * ov[e][3]); }
    PART[(h * 32 + j) * 2 + hi] = ss;
    __syncthreads();
    float tot = 0.f;
#pragma unroll
    for (int w2 = 0; w2 < 8; ++w2) { tot += PART[(w2 * 32 + j) * 2] + PART[(w2 * 32 + j) * 2 + 1]; }
    const float rs = 1.0f / sqrtf(tot * (1.0f / DATT) + EPS);
    bf16_t* zp = Z + (rowbase + q0 + j) * 1024 + 512 + h * 64 + 32 * hi;
#pragma unroll
    for (int e = 0; e < 4; ++e) { const f32x4 a = ov[2 * e] * rs, c = ov[2 * e + 1] * rs; u32x4 w;
        w.x = cvt_pk_bf16(a[0], a[1]); w.y = cvt_pk_bf16(a[2], a[3]); w.z = cvt_pk_bf16(c[0], c[1]); w.w = cvt_pk_bf16(c[2], c[3]); *(u32x4*)(zp + 8 * e) = w; }
    __syncthreads();
}


#define LAS __attribute__((address_space(3)))
#define XB_TMO      128
#define XB_XCNT(j)  (256  + 64 * (j))
#define XB_XSUB(j)  (1280 + 64 * (j))
#define XB_XGEN(j)  (2304 + 64 * (j))
#define XB_TOP      3328
#define XB_TOPGEN   3392
#define XCD_BAR_WORDS 3456
#define XB_SPIN_CAP (1u << 18)
__device__ __forceinline__ unsigned xb_ld(unsigned* p)              { return __hip_atomic_load(p, __ATOMIC_RELAXED, __HIP_MEMORY_SCOPE_AGENT); }
__device__ __forceinline__ unsigned xb_add(unsigned* p, unsigned v) { return __hip_atomic_fetch_add(p, v, __ATOMIC_RELAXED, __HIP_MEMORY_SCOPE_AGENT); }
__device__ __forceinline__ unsigned xb_xcc_id() { return (unsigned)__builtin_amdgcn_s_getreg((3 << 11) | 20) & 0xFu; }
#define XB_SPIN(cond, bar) do { unsigned _sp = 0; while (cond) { __builtin_amdgcn_s_sleep(1); \
    if ((++_sp & 255u) == 0u) { if (xb_ld(&(bar)[XB_TMO])) break; if (_sp > XB_SPIN_CAP) { atomicAdd(&(bar)[XB_TMO], 1u); break; } } } } while (0)
struct XcdBarrier { unsigned* bar; unsigned x; volatile LAS unsigned* st; };
__device__ __forceinline__ XcdBarrier xcd_barrier_post(unsigned* bar, volatile LAS unsigned* st) {
    XcdBarrier b; b.bar = bar; b.x = xb_xcc_id(); b.st = st;
    if (threadIdx.x == 0) (void)xb_add(&bar[XB_XCNT(b.x)], 1u);
    return b;
}
__device__ __forceinline__ void xcd_barrier_complete(unsigned* bar, unsigned x, unsigned& nloc, unsigned& nx) {
    const unsigned G = gridDim.x * gridDim.y * gridDim.z;
    unsigned sum, cnt, mine, sp = 0u;
    for (;;) {
        sum = 0u; cnt = 0u; mine = 0u;
#pragma unroll
        for (unsigned j = 0; j < 16; ++j) { const unsigned c = xb_ld(&bar[XB_XCNT(j)]); sum += c; cnt += (c > 0u) ? 1u : 0u; mine = (j == x) ? c : mine; }
        if (sum == G) break;
        __builtin_amdgcn_s_sleep(1);
        if ((++sp & 255u) == 0u) { if (xb_ld(&bar[XB_TMO])) break; if (sp > XB_SPIN_CAP) { atomicAdd(&bar[XB_TMO], 1u); break; } }
    }
    nloc = mine > 0u ? mine : 1u; nx = cnt > 0u ? cnt : 1u;
}
__device__ __forceinline__ void xcd_barrier(const XcdBarrier& b) {
    asm volatile("s_waitcnt vmcnt(0)" ::: "memory");
    __syncthreads();
    if (threadIdx.x == 0) {
        unsigned* bar = b.bar;
        __builtin_amdgcn_s_waitcnt(0);
        unsigned nloc = b.st[0], nx = b.st[1];
        if (nloc == 0u) { xcd_barrier_complete(bar, b.x, nloc, nx); b.st[0] = nloc; b.st[1] = nx; }
        const unsigned old = xb_add(&bar[XB_XSUB(b.x)], 1u);
        const unsigned gen = old / nloc;
        if (old + 1u == (gen + 1u) * nloc) {
            __builtin_amdgcn_fence(__ATOMIC_RELEASE, "agent");
            asm volatile("s_waitcnt vmcnt(0)" ::: "memory");
            const unsigned og = xb_add(&bar[XB_TOP], 1u);
            const unsigned tg = og / nx;
            if (og + 1u == (tg + 1u) * nx) xb_add(&bar[XB_TOPGEN], 1u);
            else XB_SPIN(xb_ld(&bar[XB_TOPGEN]) == tg, bar);
            __builtin_amdgcn_fence(__ATOMIC_ACQUIRE, "agent");
            xb_add(&bar[XB_XGEN(b.x)], 1u);
            asm volatile("s_waitcnt vmcnt(0)" ::: "memory");
        } else {
            XB_SPIN(xb_ld(&bar[XB_XGEN(b.x)]) == gen, bar);
            __builtin_amdgcn_fence(__ATOMIC_ACQUIRE, "agent");
            asm volatile("s_waitcnt vmcnt(0)" ::: "memory");
        }
    }
    __syncthreads();
}

__global__ void __launch_bounds__(NTHR, 2) hymba_fwd(Args A) {
    extern __shared__ __attribute__((aligned(16))) unsigned char lds[];
    cg::grid_group grid = cg::this_grid();
    const int G = gridDim.x, bx = blockIdx.x;
    PG8_LAS unsigned char* lds3 = (PG8_LAS unsigned char*)lds;
    volatile LAS unsigned* MISC = (volatile LAS unsigned*)(lds3 + MISC_OFF);
    if (threadIdx.x < 32) MISC[threadIdx.x] = 0u;
    __syncthreads();
    XcdBarrier bar = xcd_barrier_post((unsigned*)(A.ws + WS_CTL) + CW_BAR, MISC + 8);
#ifdef PROBE_A
    volatile LAS unsigned long long* STAMP = (volatile LAS unsigned long long*)(lds3 + MISC_OFF + 128);
#define STAMPIT(i) do { if (threadIdx.x == 0) STAMP[i] = __builtin_amdgcn_s_memrealtime(); } while (0)
#ifndef PROBE_BX
#define PROBE_BX 0
#endif
#else
#define STAMPIT(i) do {} while (0)
#endif
    STAMPIT(0);

#ifndef NO_P0
    p0_prologue(A, (char*)lds, G);
#endif
    if (A.ws == nullptr) grid.sync();
    xcd_barrier(bar);
    STAMPIT(1);

#ifndef NO_P1
    {
        pg8::Gemm g{(const bf16_t*)(A.ws + WS_XN), (const bf16_t*)(A.ws + WS_WIN), MTOK, 1536, DM}; pg8::StaticOrder S; S.init(MTOK, 1536, G, bx);
        pg8::EpiStore E{(bf16_t*)(A.ws + WS_PROJ), PROJ_LD};
        pg8::gemm_phase<pg8::EpiStore, pg8::StaticOrder, true, true, false>(lds3, g, S, E, nullptr, 0.f);
        pg8::Gemm g2{(const bf16_t*)(A.ws + WS_WIN) + (size_t)1536 * DM, (const bf16_t*)(A.ws + WS_XN), 512, MTOK, DM}; pg8::StaticOrder S2; S2.init(512, MTOK, G, bx);
        pg8::EpiStore E2{(bf16_t*)(A.ws + WS_VT), VT_LD};
        pg8::gemm_phase<pg8::EpiStore, pg8::StaticOrder, true, true, false>(lds3, g2, S2, E2, nullptr, 0.f);
    }
#endif
    xcd_barrier(bar);
    STAMPIT(2);

#ifndef NO_SSM
    for (int it = bx; it < NB * NGRP; it += G) ssm_item(A, it >> 5, it & 31, (char*)lds);
#endif
    STAMPIT(9);
#ifndef NO_ATT
    for (int it = bx; it < NB * (SEQ / 32); it += G) attn_item(A, it >> 7, it & 127, (char*)lds);
#endif
    STAMPIT(10);
    xcd_barrier(bar);
    STAMPIT(3);

#ifndef NO_P3
    {
        pg8::Gemm g{(const bf16_t*)(A.ws + WS_YG), (const bf16_t*)(A.ws + WS_WGLU), MTOK, 512, 512}; pg8::StaticOrder S; S.init(MTOK, 512, G, bx);
        pg8::EpiGlu E{(const bf16_t*)(A.ws + WS_YG), (bf16_t*)(A.ws + WS_Z), (float*)(A.ws + WS_PART1)};
        pg8::gemm_phase<pg8::EpiGlu, pg8::StaticOrder, true, true, false>(lds3, g, S, E, nullptr, 0.f);
    }
#endif
    xcd_barrier(bar);
    STAMPIT(4);

#ifndef NO_P4
    {
        pg8::Gemm g{(const bf16_t*)(A.ws + WS_Z), (const bf16_t*)(A.ws + WS_WOUT), MTOK, DM, DM}; pg8::StaticOrder S; S.init(MTOK, DM, G, bx);
        pg8::EpiRes<false> E{A.x, nullptr, nullptr, (bf16_t*)(A.ws + WS_XN), (float*)(A.ws + WS_PART2)};
        pg8::gemm_phase<pg8::EpiRes<false>, pg8::StaticOrder, true, true, true>(lds3, g, S, E, (const float*)(A.ws + WS_PART1), EPS);
    }
#endif
    xcd_barrier(bar);
    STAMPIT(5);

#ifndef NO_P5
    {
        pg8::Gemm g{(const bf16_t*)(A.ws + WS_XN), (const bf16_t*)(A.ws + WS_WGU), MTOK, 2 * DFF, DM}; pg8::StaticOrder S; S.init(MTOK, 2 * DFF, G, bx);
        pg8::EpiGateUp E{(bf16_t*)(A.ws + WS_H), (const float*)(A.ws + WS_PART2), EPS};
        pg8::gemm_phase<pg8::EpiGateUp, pg8::StaticOrder, true, true, false>(lds3, g, S, E, nullptr, 0.f);
    }
#endif
    xcd_barrier(bar);
    STAMPIT(6);

#ifndef NO_P6
    {
        pg8::Gemm g{(const bf16_t*)(A.ws + WS_H), (const bf16_t*)(A.ws + WS_WDN), MTOK, DM, DFF}; pg8::StaticOrder S; S.init(MTOK, DM, G, bx);
        pg8::EpiRes<true> E{nullptr, (const bf16_t*)(A.ws + WS_XN), A.out, nullptr, (float*)(A.ws + WS_PART3)};
        pg8::gemm_phase<pg8::EpiRes<true>, pg8::StaticOrder, true, true, false>(lds3, g, S, E, nullptr, 0.f);
    }
#endif
    xcd_barrier(bar);
    STAMPIT(7);

    {
        int tid7 = threadIdx.x; asm volatile("" : "+v"(tid7));
        const int wave = tid7 >> 6, lane = tid7 & 63;
        const int gw = bx * NWAVES + wave, NGW = G * NWAVES;
        f32x4 gv[4];
#pragma unroll
        for (int j = 0; j < 4; ++j) gv[j] = ((const f32x4*)A.final_norm_g)[lane + 64 * j];
        const float* part = (const float*)(A.ws + WS_PART3);
        for (int m = gw; m < MTOK; m += NGW) {
            const f32x4* pp = (const f32x4*)(part + (size_t)m * 16); const f32x4 p0 = pp[0], p1 = pp[1], p2 = pp[2], p3 = pp[3];
            const float s = ((p0[0] + p0[1]) + (p0[2] + p0[3])) + ((p1[0] + p1[1]) + (p1[2] + p1[3])) + ((p2[0] + p2[1]) + (p2[2] + p2[3])) + ((p3[0] + p3[1]) + (p3[2] + p3[3]));
            const float rs = 1.0f / sqrtf(s * (1.0f / DM) + EPS);
            f32x4* xr = (f32x4*)(A.out + (size_t)m * DM) + lane;
#pragma unroll
            for (int j = 0; j < 4; ++j) { const f32x4 v = xr[64 * j]; xr[64 * j] = v * rs * gv[j]; }
        }
    }
#ifdef PROBE_A
    STAMPIT(8);
    if (bx == PROBE_BX && threadIdx.x == 0) { const unsigned long long dt = STAMP[PROBE_B] - STAMP[PROBE_A]; const unsigned long long t0 = __builtin_amdgcn_s_memrealtime(); while (__builtin_amdgcn_s_memrealtime() - t0 < dt) __builtin_amdgcn_s_sleep(8); }
#endif
}

extern "C" void kernel_launch(void* const* d_in, const int* in_sizes, int n_in, void* d_out, int out_size, void* d_ws, size_t ws_size, hipStream_t stream) {
    static int grid = 0;
    if (grid == 0) {
        if (n_in != 20 || in_sizes[0] != MTOK * DM || out_size != MTOK * DM || ws_size < WS_END) { fprintf(stderr, "kernel_launch: unexpected problem shape / workspace (%d inputs, ws %zu)\n", n_in, ws_size); grid = -1; return; }
        int dev = 0, cus = 0, per_cu = 0;
        if (hipGetDevice(&dev) != hipSuccess || hipDeviceGetAttribute(&cus, hipDeviceAttributeMultiprocessorCount, dev) != hipSuccess) { grid = -1; return; }
        if (hipFuncSetAttribute((const void*)hymba_fwd, hipFuncAttributeMaxDynamicSharedMemorySize, LDS_BYTES) != hipSuccess) { fprintf(stderr, "kernel_launch: hipFuncSetAttribute failed\n"); grid = -1; return; }
        if (hipOccupancyMaxActiveBlocksPerMultiprocessor(&per_cu, (const void*)hymba_fwd, NTHR, LDS_BYTES) != hipSuccess || per_cu < 1) { fprintf(stderr, "kernel_launch: occupancy query says %d\n", per_cu); per_cu = 1; }
        (void)hipGetLastError();
        grid = cus * 1;
    }
    if (grid < 0) return;
    if (hipMemsetAsync((char*)d_ws + WS_CTL, 0, CTL_ZERO_BYTES, stream) != hipSuccess) { fprintf(stderr, "kernel_launch: memset failed\n"); return; }
    Args a{};
    const float** f = (const float**)&a;
    for (int i = 0; i < 20; ++i) f[i] = (const float*)d_in[i];
    a.out = (float*)d_out; a.ws = (unsigned char*)d_ws;
    void* args[] = {&a};
    hipError_t e = hipLaunchCooperativeKernel((const void*)hymba_fwd, dim3(grid), dim3(NTHR), args, LDS_BYTES, stream);
    if (e != hipSuccess) fprintf(stderr, "cooperative launch failed: %s (grid %d)\n", hipGetErrorString(e), grid);
}
```
